# Optimizing an MI355X kernel written in HIP

```python
import math
import jax, jax.numpy as jnp
from jax import lax
import numpy as np

D_MODEL = 1024
BATCH = 16
SEQ = 2048
DEPTH = 2
DEC_BATCH = 32
DEC_SEQ = 8
PAST_LEN = 16384
PAGE_SIZE = 128

GLA_HEADS = 4
GLA_DK = D_MODEL // 2
GLA_DV = D_MODEL
GLA_DK_HEAD = GLA_DK // GLA_HEADS
GLA_DV_HEAD = GLA_DV // GLA_HEADS
GATE_RANK = 16
GATE_TAU = 16.0
GLA_CHUNK = 64
WINDOWS = (128, 512, 2048)
DILATIONS = (1, 4, 16)
N_GROUPS = 3
HEAD_DIM = 64
HEADS_PER_GROUP = D_MODEL // HEAD_DIM
KV_HEADS = 4
Q_PER_KV = HEADS_PER_GROUP // KV_HEADS
Q_BLOCK = 128
N_BUCKETS = 32
MAX_EXACT = 16
MAX_DISTANCE = 2048
D_FF = -(-8 * D_MODEL // (3 * 256)) * 256
EPS = 1e-6

kernel_name = 'yoco_gla_dilated_swa_decode_step'


def rmsnorm(x, g):
    x32 = x.astype(jnp.float32)
    y = x32 * lax.rsqrt(jnp.mean(x32 * x32, axis=-1, keepdims=True) + EPS)
    return (y * g.astype(jnp.float32)).astype(x.dtype)


def swiglu(u, w_gate_up, w_down):
    gate, up = jnp.split(u @ w_gate_up, 2, axis=-1)
    return (jax.nn.silu(gate) * up) @ w_down


def t5_buckets(dist):
    d = np.asarray(dist)
    large = MAX_EXACT + (np.log(np.maximum(d, 1) / MAX_EXACT) / np.log(MAX_DISTANCE / MAX_EXACT)
                         * (N_BUCKETS - MAX_EXACT)).astype(np.int64)
    large = np.minimum(large, N_BUCKETS - 1)
    return np.where(d < MAX_EXACT, d, large).astype(np.int32)


def gla_recurrence(q, k, v, g, s0):
    B, T, H, DK = q.shape
    DV = v.shape[-1]
    c = math.gcd(T, GLA_CHUNK)
    n = T // c

    def blocks(a):
        return a.astype(jnp.float32).reshape(B, n, c, H, a.shape[-1]).transpose(1, 0, 3, 2, 4)

    causal = jnp.tril(jnp.ones((c, c), dtype=bool))

    def step(s, inp):
        qc, kc, vc, gc = inp
        b = jnp.cumsum(gc, axis=2)
        o_inter = jnp.einsum('bhid,bhde->bhie', qc * jnp.exp(b), s)
        diff = b[:, :, :, None, :] - b[:, :, None, :, :]
        decay = jnp.exp(jnp.where(causal[:, :, None], diff, -jnp.inf))
        attn = jnp.sum(qc[:, :, :, None, :] * kc[:, :, None, :, :] * decay, axis=-1)
        o_intra = jnp.einsum('bhij,bhje->bhie', attn, vc)
        b_last = b[:, :, -1, :]
        s_new = jnp.exp(b_last)[..., None] * s + jnp.einsum(
            'bhjd,bhje->bhde', kc * jnp.exp(b_last[:, :, None, :] - b), vc)
        return s_new, o_inter + o_intra

    s, o = lax.scan(step, s0.astype(jnp.float32), (blocks(q), blocks(k), blocks(v), blocks(g)))
    o = o.transpose(1, 0, 3, 2, 4).reshape(B, T, H, DV)
    return o, s


def gla_mixer(u, s0, w_in, w_a2, b_a, g_onorm, w_o):
    B, T, _ = u.shape
    p = u @ w_in
    q, k, v, r, a = jnp.split(p, [GLA_DK, 2 * GLA_DK, 2 * GLA_DK + GLA_DV, 2 * GLA_DK + 2 * GLA_DV], axis=-1)
    q = q.reshape(B, T, GLA_HEADS, GLA_DK_HEAD) * GLA_DK_HEAD ** -0.5
    k = k.reshape(B, T, GLA_HEADS, GLA_DK_HEAD)
    v = v.reshape(B, T, GLA_HEADS, GLA_DV_HEAD)
    g = jax.nn.log_sigmoid((a @ w_a2 + b_a).astype(jnp.float32)) / GATE_TAU
    g = g.reshape(B, T, GLA_HEADS, GLA_DK_HEAD)
    o, s = gla_recurrence(q, k, v, g, s0)
    o = rmsnorm(o, g_onorm).astype(u.dtype).reshape(B, T, GLA_DV)
    o = o * jax.nn.silu(r)
    return o @ w_o, s.astype(u.dtype)


def dilated_group(q, kv, start, dil, n_keys, bias):
    Tq = q.shape[1]
    q_pos = start + jnp.arange(Tq)
    idx = q_pos[:, None] - dil * jnp.arange(n_keys)[None, :]
    valid = idx >= 0
    kvg = kv[:, jnp.maximum(idx, 0)]
    s = jnp.einsum('bqhgd,bqkhd->bqhgk', q, kvg[:, :, :, 0]).astype(jnp.float32) * HEAD_DIM ** -0.5
    s = jnp.where(valid[None, :, None, None, :], s + bias, -jnp.inf)
    m = jnp.max(s, axis=-1, keepdims=True)
    p = jnp.exp(s - m)
    l = jnp.sum(p, axis=-1, keepdims=True)
    o = jnp.einsum('bqhgk,bqkhd->bqhgd', (p / l).astype(kv.dtype), kvg[:, :, :, 1])
    lse = (m + jnp.log(l))[..., 0]
    return o, lse


def mix_groups(q, starts, kvs, biases):
    outs, lses = [], []
    for gi in range(N_GROUPS):
        o, lse = dilated_group(q[:, :, gi], kvs[gi], starts[gi], DILATIONS[gi],
                               WINDOWS[gi] // DILATIONS[gi] + 1, biases[gi])
        outs.append(o.astype(jnp.float32))
        lses.append(lse)
    w = jax.nn.softmax(jnp.stack(lses, axis=0), axis=0)
    o = jnp.sum(w[..., None] * jnp.stack(outs, axis=0), axis=0)
    return o.astype(q.dtype)


def dilated_mixer(u, kvs, starts, w_q, w_o, biases):
    B, T, _ = u.shape
    q = (u @ w_q).reshape(B, T, N_GROUPS, KV_HEADS, Q_PER_KV, HEAD_DIM)
    if starts is None:
        nblk = T // Q_BLOCK
        qb = q.reshape(B, nblk, Q_BLOCK, N_GROUPS, KV_HEADS, Q_PER_KV, HEAD_DIM).swapaxes(0, 1)

        def blk(args):
            qi, i = args
            start = i * Q_BLOCK
            return mix_groups(qi, (start,) * N_GROUPS, kvs, biases)

        o = lax.map(blk, (qb, jnp.arange(nblk)))
        o = o.swapaxes(0, 1).reshape(B, T, HEADS_PER_GROUP * HEAD_DIM)
    else:
        o = mix_groups(q, starts, kvs, biases).reshape(B, T, HEADS_PER_GROUP * HEAD_DIM)
    return o @ w_o


def trunk(x, gla_s0, win_past, norm_g, w_in_a, w_a2, b_a, g_onorm, w_o_a, g_kv, w_kv,
          w_q_b, w_o_b, rel_bias, w_gate_up, w_down):
    n_a = DEPTH // 2
    B, T, _ = x.shape
    biases = []
    for gi in range(N_GROUPS):
        nk = WINDOWS[gi] // DILATIONS[gi] + 1
        bk = jnp.asarray(t5_buckets(DILATIONS[gi] * np.arange(nk)))
        tab = rel_bias[bk][:, gi * HEADS_PER_GROUP:(gi + 1) * HEADS_PER_GROUP]
        biases.append(tab.T.reshape(KV_HEADS, Q_PER_KV, nk).astype(jnp.float32))
    h = x
    gla_states = []
    kvs, starts, win_new = None, None, None
    for l in range(DEPTH):
        if l < n_a:
            y, s = gla_mixer(rmsnorm(h, norm_g[l, 0]), gla_s0[l], w_in_a[l], w_a2[l], b_a[l],
                             g_onorm[l], w_o_a[l])
            gla_states.append(s)
        else:
            if l == n_a:
                kv = (rmsnorm(h, g_kv) @ w_kv).reshape(B, T, N_GROUPS, 2, KV_HEADS, HEAD_DIM)
                kvs, starts, win_new = [], [], []
                for gi in range(N_GROUPS):
                    new = kv[:, :, gi]
                    if win_past is None:
                        full, start = new, 0
                    else:
                        full = jnp.concatenate([win_past[gi].astype(new.dtype), new], axis=1)
                        start = win_past[gi].shape[1]
                    kvs.append(full)
                    starts.append(start)
                    win_new.append(full[:, full.shape[1] - min(WINDOWS[gi], full.shape[1]):])
            y = dilated_mixer(rmsnorm(h, norm_g[l, 0]), kvs, None if win_past is None else tuple(starts),
                              w_q_b[l - n_a], w_o_b[l - n_a], biases)
        h = h + rmsnorm(y, norm_g[l, 1])
        h = h + rmsnorm(swiglu(rmsnorm(h, norm_g[l, 2]), w_gate_up[l], w_down[l]), norm_g[l, 3])
    return h, jnp.stack(gla_states, axis=0), win_new


def setup_inputs(seed: int = 0) -> dict:
    key = jax.random.key(seed)
    ks = jax.random.split(key, 20)
    n_a = DEPTH // 2
    n_b = DEPTH - n_a
    f32 = jnp.float32
    nrm = lambda k, shp, sc: jax.random.normal(k, shp, f32) * sc
    x_prompt = nrm(ks[0], (BATCH, SEQ, D_MODEL), 1.0)
    x_sample = nrm(ks[1], (DEC_BATCH, DEC_SEQ, D_MODEL), 1.0)
    state_gla = nrm(ks[2], (n_a, DEC_BATCH, GLA_HEADS, GLA_DK_HEAD, GLA_DV_HEAD), 0.5)
    cache_win1 = nrm(ks[3], (DEC_BATCH, min(WINDOWS[0], PAST_LEN), 2, KV_HEADS, HEAD_DIM), 1.0)
    cache_win2 = nrm(ks[4], (DEC_BATCH, min(WINDOWS[1], PAST_LEN), 2, KV_HEADS, HEAD_DIM), 1.0)
    cache_win3 = nrm(ks[5], (DEC_BATCH, min(WINDOWS[2], PAST_LEN), 2, KV_HEADS, HEAD_DIM), 1.0)
    norm_g = 1.0 + nrm(ks[6], (DEPTH, 4, D_MODEL), 0.02)
    w_in_a = nrm(ks[7], (n_a, D_MODEL, 2 * GLA_DK + 2 * GLA_DV + GATE_RANK), D_MODEL ** -0.5)
    w_a2 = nrm(ks[8], (n_a, GATE_RANK, GLA_DK), GATE_RANK ** -0.5)
    b_a = nrm(ks[9], (n_a, GLA_DK), 0.1)
    g_onorm = 1.0 + nrm(ks[10], (n_a, GLA_DV_HEAD), 0.02)
    w_o_a = nrm(ks[11], (n_a, GLA_DV, D_MODEL), GLA_DV ** -0.5)
    g_kv = 1.0 + nrm(ks[12], (D_MODEL,), 0.02)
    w_kv = nrm(ks[13], (D_MODEL, N_GROUPS * 2 * KV_HEADS * HEAD_DIM), D_MODEL ** -0.5)
    w_q_b = nrm(ks[14], (n_b, D_MODEL, N_GROUPS * HEADS_PER_GROUP * HEAD_DIM), D_MODEL ** -0.5)
    w_o_b = nrm(ks[15], (n_b, HEADS_PER_GROUP * HEAD_DIM, D_MODEL), (HEADS_PER_GROUP * HEAD_DIM) ** -0.5)
    rel_bias = nrm(ks[16], (N_BUCKETS, N_GROUPS * HEADS_PER_GROUP), 0.1)
    w_gate_up = nrm(ks[17], (DEPTH, D_MODEL, 2 * D_FF), D_MODEL ** -0.5)
    w_down = nrm(ks[18], (DEPTH, D_FF, D_MODEL), D_FF ** -0.5)
    return {'x_prompt': x_prompt, 'x_sample': x_sample, 'state_gla': state_gla,
            'cache_win1': cache_win1, 'cache_win2': cache_win2, 'cache_win3': cache_win3,
            'norm_g': norm_g, 'w_in_a': w_in_a, 'w_a2': w_a2, 'b_a': b_a, 'g_onorm': g_onorm,
            'w_o_a': w_o_a, 'g_kv': g_kv, 'w_kv': w_kv, 'w_q_b': w_q_b, 'w_o_b': w_o_b,
            'rel_bias': rel_bias, 'w_gate_up': w_gate_up, 'w_down': w_down}


def reference(x_prompt, x_sample, state_gla, cache_win1, cache_win2, cache_win3, norm_g, w_in_a,
              w_a2, b_a, g_onorm, w_o_a, g_kv, w_kv, w_q_b, w_o_b, rel_bias, w_gate_up, w_down):
    n_a = DEPTH // 2
    s0_prompt = jnp.zeros((n_a, x_prompt.shape[0], GLA_HEADS, GLA_DK_HEAD, GLA_DV_HEAD), x_prompt.dtype)
    y_prompt, gla_prompt, win_prompt = trunk(
        x_prompt, s0_prompt, None, norm_g, w_in_a, w_a2, b_a, g_onorm, w_o_a, g_kv, w_kv,
        w_q_b, w_o_b, rel_bias, w_gate_up, w_down)
    y_sample, gla_sample, win_sample = trunk(
        x_sample, state_gla, (cache_win1, cache_win2, cache_win3), norm_g, w_in_a, w_a2, b_a,
        g_onorm, w_o_a, g_kv, w_kv, w_q_b, w_o_b, rel_bias, w_gate_up, w_down)
    return (y_prompt, y_sample, gla_prompt, win_prompt[0], win_prompt[1], win_prompt[2],
            gla_sample, win_sample[0], win_sample[1], win_sample[2])
```

```cpp
#include <hip/hip_runtime.h>
#include <hip/hip_cooperative_groups.h>
#include <cstdio>
#include <cstdint>
namespace cg = cooperative_groups;

constexpr int D = 1024, PB = 16, PT = 2048, SB = 32, ST = 8, PAST = 16384;
constexpr int NP = PB * PT;
constexpr int NS = SB * ST;
constexpr int MT = NP + NS;
constexpr int GH = 4, GDK = 128, GDV = 256, RANK = 16;
constexpr int NIN = 3088;
constexpr int NWIN = 3072;
constexpr int FF = 2816, NGU = 2 * FF;
constexpr int NKV = 1536, NQ = 3072, NKVQ = NKV + NQ;
constexpr int NKEYS = 129;
constexpr float EPS = 1e-6f;
constexpr size_t OFF_YP = 0, OFF_YS = 33554432, OFF_GLAP = 33816576, OFF_W1P = 35913728, OFF_W2P = 36962304, OFF_W3P = 41156608,
                 OFF_GLAS = 57933824, OFF_W1S = 62128128, OFF_W2S = 64225280, OFF_W3S = 72613888, OUT_TOTAL = 106168320;
constexpr size_t MiB = 1u << 20;
constexpr size_t WS_CTL = 0;
constexpr size_t WS_WIN = 1 * MiB;
constexpr size_t WS_WOA = WS_WIN + 6 * MiB;
constexpr size_t WS_WGU0 = WS_WOA + 2 * MiB;
constexpr size_t WS_WD0 = WS_WGU0 + 11 * MiB;
constexpr size_t WS_WKVQ = WS_WD0 + 11 * MiB / 2;
constexpr size_t WS_WOB = WS_WKVQ + 9 * MiB;
constexpr size_t WS_WGU1 = WS_WOB + 2 * MiB;
constexpr size_t WS_WD1 = WS_WGU1 + 11 * MiB;
constexpr size_t WS_ABUF = 53 * MiB;
constexpr size_t WS_BIAS = 55 * MiB + 512 * 1024;
constexpr size_t WS_XB0 = 56 * MiB;
constexpr size_t WS_XB1 = 121 * MiB;
constexpr size_t WS_BIG = 186 * MiB;
constexpr size_t WS_YKV = 380 * MiB;
constexpr size_t WS_END = 509 * MiB;
static_assert(WS_WD1 + 11 * MiB / 2 <= WS_ABUF && WS_ABUF + (size_t)MT * 16 * 4 <= WS_BIAS && WS_XB0 + (size_t)MT * D * 2 <= WS_XB1 &&
              WS_XB1 + (size_t)MT * D * 2 <= WS_BIG && WS_BIG + (size_t)MT * 3072 * 2 <= WS_YKV && WS_YKV + (size_t)MT * D * 4 <= WS_END, "d_ws map");

constexpr int LDS_BYTES = 147456;
constexpr int NWAVES = 8;
constexpr int NPHASE = 15;

#define LAS __attribute__((address_space(3)))
typedef unsigned short bf16;
typedef float f32x4 __attribute__((ext_vector_type(4)));
typedef float f32x2 __attribute__((ext_vector_type(2)));
typedef unsigned u32x4 __attribute__((ext_vector_type(4)));
typedef unsigned u32x2 __attribute__((ext_vector_type(2)));
typedef __bf16 bf16x2_t __attribute__((ext_vector_type(2)));
__device__ __forceinline__ unsigned pk2(float lo, float hi) { f32x2 v = {lo, hi}; bf16x2_t b = __builtin_convertvector(v, bf16x2_t); return __builtin_bit_cast(unsigned, b); }
__device__ __forceinline__ float bf2f(unsigned short h) { return __uint_as_float((unsigned)h << 16); }
__device__ __forceinline__ float bflo(unsigned w) { return __uint_as_float(w << 16); }
__device__ __forceinline__ float bfhi(unsigned w) { return __uint_as_float(w & 0xffff0000u); }
__device__ __forceinline__ float wave_sum(float v) {
#pragma unroll
    for (int o = 1; o < 64; o <<= 1) v += __shfl_xor(v, o);
    return v;
}
__device__ __forceinline__ float wave_max(float v) {
#pragma unroll
    for (int o = 1; o < 64; o <<= 1) v = fmaxf(v, __shfl_xor(v, o));
    return v;
}
__device__ __forceinline__ float silu_f(float x) { return x * __builtin_amdgcn_rcpf(1.f + __expf(-x)); }

namespace pg8 {
#define PG8_LAS __attribute__((address_space(3)))
typedef unsigned short bf16_t;
typedef short bf16x8 __attribute__((ext_vector_type(8)));
typedef float f32x4 __attribute__((ext_vector_type(4)));
typedef unsigned u32x4 __attribute__((ext_vector_type(4)));
constexpr int BM = 256, BK = 64, HALF = 128, HTB = HALF * BK * 2  , STAGE_BYTES = 8 * HTB, NXCD = 8, WGM = 8;

__host__ __device__ __forceinline__ int lds_byte(int r, int c) { const int st = (r >> 4) * 2 + (c >> 5), rr = r & 15, cc = c & 31, ob = rr * 64 + cc * 2; return st * 1024 + (ob ^ (((ob >> 9) & 1) << 5)); }
__host__ __device__ __forceinline__ void stage_rc(int b, int& R, int& C) { const int st = b / 1024, sb = b % 1024, swz = sb ^ (((sb >> 9) & 1) << 5); R = (st >> 1) * 16 + swz / 64; C = (st & 1) * 32 + (swz % 64) / 2; }
__host__ __device__ __forceinline__ int perm32(int rho) { const int n = rho >> 4, i = rho & 15; return 8 * (i >> 2) + 4 * n + (i & 3); }

struct Unit { int pm, pn; };
struct Gemm { const bf16_t* A; const bf16_t* Bt; int M, N, K; };

struct StaticOrder {
    int nM, nN, nwg, G, c;
    __host__ __device__ void init(int M, int N, int G_, int c_) { nM = M / BM; nN = N / BM; nwg = nM * nN; G = G_; c = c_; }
    __host__ __device__ bool next(int i, Unit& u) const {
        const long L = (long)i * G + c; if (L >= nwg) return false;
        int wgid = (int)L; { const int q = nwg / NXCD, r = nwg % NXCD, xcd = wgid % NXCD, off = wgid / NXCD; wgid = (xcd < r ? xcd * (q + 1) : r * (q + 1) + (xcd - r) * q) + off; }
        const int nig = WGM * nN, gid = wgid / nig, fm = gid * WGM, gsz = (nM - fm) < WGM ? (nM - fm) : WGM;
        u.pm = fm + ((wgid % nig) % gsz); u.pn = (wgid % nig) / gsz; return true;
    }
    __device__ __forceinline__ void a_ready(const Unit&) const {}
    __device__ __forceinline__ void done(const Unit&) const {}
};


__device__ __forceinline__ unsigned epk2(float lo, float hi) { return ::pk2(lo, hi); }
struct EpiBf16 {
    static constexpr bool PERM = true, AFTER_DRAIN = false;
    bf16_t* O; int ldc;
    __device__ __forceinline__ void operator()(const f32x4 (&acc)[2][2][4][2], const Unit& u, int wr, int wc, int fr, int fq) const {
        const int row0 = u.pm * BM + wr * 64 + fr, col0 = u.pn * BM + wc * 32 + 8 * fq;
#pragma unroll
        for (int ai = 0; ai < 2; ++ai)
#pragma unroll
            for (int m = 0; m < 4; ++m) { bf16_t* rowp = O + (size_t)(row0 + ai * HALF + m * 16) * ldc + col0;
#pragma unroll
                for (int bj = 0; bj < 2; ++bj) { const f32x4 v0 = acc[ai][bj][m][0], v1 = acc[ai][bj][m][1];
                    u32x4 w; w.x = epk2(v0[0], v0[1]); w.y = epk2(v0[2], v0[3]); w.z = epk2(v1[0], v1[1]); w.w = epk2(v1[2], v1[3]);
                    *(u32x4*)(rowp + bj * HALF) = w; } }
    }
};
struct EpiF32 {
    static constexpr bool PERM = false, AFTER_DRAIN = false;
    float* C; int ldc;
    __device__ __forceinline__ void operator()(const f32x4 (&acc)[2][2][4][2], const Unit& u, int wr, int wc, int fr, int fq) const {
        const int row0 = u.pm * BM + wr * 64 + fr, col0 = u.pn * BM + wc * 32 + 4 * fq;
#pragma unroll
        for (int ai = 0; ai < 2; ++ai)
#pragma unroll
            for (int m = 0; m < 4; ++m) { float* rowp = C + (size_t)(row0 + ai * HALF + m * 16) * ldc + col0;
#pragma unroll
                for (int bj = 0; bj < 2; ++bj)
#pragma unroll
                    for (int n = 0; n < 2; ++n) *(f32x4*)(rowp + bj * HALF + n * 16) = acc[ai][bj][m][n]; }
    }
};
struct EpiSwiGLU {
    static constexpr bool PERM = true, AFTER_DRAIN = false;
    bf16_t* Hd; int ldh;
    __device__ __forceinline__ void operator()(const f32x4 (&acc)[2][2][4][2], const Unit& u, int wr, int wc, int fr, int fq) const {
        const int row0 = u.pm * BM + wr * 64 + fr, col0 = u.pn * HALF + wc * 32 + 8 * fq;
#pragma unroll
        for (int ai = 0; ai < 2; ++ai)
#pragma unroll
            for (int m = 0; m < 4; ++m) { bf16_t* rowp = Hd + (size_t)(row0 + ai * HALF + m * 16) * ldh + col0;
                const f32x4 g0 = acc[ai][0][m][0], g1 = acc[ai][0][m][1], u0 = acc[ai][1][m][0], u1 = acc[ai][1][m][1];
                float h[8];
#pragma unroll
                for (int i = 0; i < 4; ++i) { h[i] = ::silu_f(g0[i]) * u0[i]; h[4 + i] = ::silu_f(g1[i]) * u1[i]; }
                u32x4 w; w.x = epk2(h[0], h[1]); w.y = epk2(h[2], h[3]); w.z = epk2(h[4], h[5]); w.w = epk2(h[6], h[7]);
                *(u32x4*)rowp = w; }
    }
};
struct EpiKVQ {
    static constexpr bool PERM = true, AFTER_DRAIN = false;
    bf16_t* KV; bf16_t* Q; float* out;
    __device__ __forceinline__ void operator()(const f32x4 (&acc)[2][2][4][2], const Unit& u, int wr, int wc, int fr, int fq) const {
        const int row0 = u.pm * BM + wr * 64 + fr; const int tcol = wc * 32 + 8 * fq;
        const bool iskv = u.pn < 6;
        bf16_t* base = iskv ? KV + u.pn * BM + tcol : Q + (u.pn - 6) * BM + tcol; const int ldc = iskv ? ::NKV : ::NQ;
        const int g = u.pn >> 1, s = u.pn & 1; const int Wg = g == 0 ? 128 : (g == 1 ? 512 : 2048);
        float* wp = out + (g == 0 ? ::OFF_W1P : (g == 1 ? ::OFF_W2P : ::OFF_W3P)); float* wsm = out + (g == 0 ? ::OFF_W1S : (g == 1 ? ::OFF_W2S : ::OFF_W3S));
#pragma unroll
        for (int ai = 0; ai < 2; ++ai)
#pragma unroll
            for (int m = 0; m < 4; ++m) { const int row = row0 + ai * HALF + m * 16; bf16_t* rowp = base + (size_t)row * ldc;
#pragma unroll
                for (int bj = 0; bj < 2; ++bj) { const f32x4 v0 = acc[ai][bj][m][0], v1 = acc[ai][bj][m][1];
                    u32x4 w; w.x = epk2(v0[0], v0[1]); w.y = epk2(v0[2], v0[3]); w.z = epk2(v1[0], v1[1]); w.w = epk2(v1[2], v1[3]);
                    *(u32x4*)(rowp + bj * HALF) = w; }
                if (iskv) {
                    float* dst = nullptr;
                    if (row < ::NP) { const int b = row >> 11, t = row & 2047, tp = t - (2048 - Wg); if (tp >= 0) dst = wp + ((size_t)(b * Wg + tp) * 512 + s * 256 + tcol); }
                    else { const int sr = row - ::NP, b = sr >> 3, r = sr & 7; dst = wsm + ((size_t)(b * Wg + (Wg - 8 + r)) * 512 + s * 256 + tcol); }
                    if (dst) {
#pragma unroll
                        for (int bj = 0; bj < 2; ++bj) { *(f32x4*)(dst + bj * HALF) = acc[ai][bj][m][0]; *(f32x4*)(dst + bj * HALF + 4) = acc[ai][bj][m][1]; } }
                } }
    }
};

template <class Epi, class Sched, bool ALIGN_EPI = false, bool SP2 = false>
__device__ __forceinline__ void gemm_phase(PG8_LAS unsigned char* lds, const Gemm g, const Sched& S, const Epi& E) {
    const int tid = threadIdx.x, wid = __builtin_amdgcn_readfirstlane(tid >> 6), lane = tid & 63, wr = wid >> 2, wc = wid & 3, fr = lane & 15, fq = lane >> 4;
    const int K = g.K, nt = K / BK;
    unsigned voffA[2], voffB[2];
#pragma unroll
    for (int i = 0; i < 2; ++i) { int R, C; stage_rc(tid * 16 + i * 8192, R, C); const int Rb = Epi::PERM ? ((R & ~31) + perm32(R & 31)) : R;
        voffA[i] = (unsigned)(R * K + C) * 2u; voffB[i] = (unsigned)(Rb * K + C) * 2u; }
    const size_t kstep = (size_t)(BK * 2);
    const size_t hstep = (size_t)HALF * K * 2;
    const size_t tstep = 2 * hstep;
    const unsigned ldsw = (unsigned)wid * 1024u;
    const int aoff = lds_byte(wr * 64 + fr, fq * 8), boff = lds_byte(wc * 32 + fr, fq * 8);
#define PG8_SA(b, h) (((b) * 2 + (h)) * HTB)
#define PG8_SB(b, h) ((4 + (b) * 2 + (h)) * HTB)
#define PG8_STAGE(bufoff, gbase, voff) do { _Pragma("unroll") for (int _i = 0; _i < 2; ++_i) \
        __builtin_amdgcn_global_load_lds((const unsigned*)((const char*)(gbase) + (voff)[_i]), (PG8_LAS unsigned*)(lds + (bufoff) + ldsw + _i * 8192), 16, 0, 0); } while (0)
#define PG8_LDA(dst, b, h) do { _Pragma("unroll") for (int m = 0; m < 4; ++m) _Pragma("unroll") for (int k = 0; k < 2; ++k) dst[m][k] = *(const PG8_LAS bf16x8*)(lds + PG8_SA(b, h) + aoff + m * 2048 + k * 1024); } while (0)
#define PG8_LDB(dst, b, h) do { _Pragma("unroll") for (int n = 0; n < 2; ++n) _Pragma("unroll") for (int k = 0; k < 2; ++k) dst[n][k] = *(const PG8_LAS bf16x8*)(lds + PG8_SB(b, h) + boff + n * 2048 + k * 1024); } while (0)
#define PG8_MMA(ai, bj, At, Bt) do { __builtin_amdgcn_s_setprio(1); _Pragma("unroll") for (int m = 0; m < 4; ++m) _Pragma("unroll") for (int n = 0; n < 2; ++n) _Pragma("unroll") for (int k = 0; k < 2; ++k) \
        acc[ai][bj][m][n] = __builtin_amdgcn_mfma_f32_16x16x32_bf16(Bt[n][k], At[m][k], acc[ai][bj][m][n], 0, 0, 0); __builtin_amdgcn_s_setprio(0); } while (0)
#define PG8_WAIT_V(n) asm volatile("s_waitcnt vmcnt(" #n ")" ::: "memory")
#define PG8_WAIT_L(n) asm volatile("s_waitcnt lgkmcnt(" #n ")" ::: "memory")
#define PG8_BAR __builtin_amdgcn_s_barrier()
#define PG8_SCHED __builtin_amdgcn_sched_barrier(0)
    Unit cur, nxt; int ui = 0;
    if (!S.next(0, cur)) return;
    f32x4 acc[2][2][4][2];
#pragma unroll
    for (int a = 0; a < 2; ++a)
#pragma unroll
        for (int b = 0; b < 2; ++b)
#pragma unroll
            for (int m = 0; m < 4; ++m)
#pragma unroll
                for (int n = 0; n < 2; ++n) acc[a][b][m][n] = (f32x4){0.f, 0.f, 0.f, 0.f};
    bf16x8 At[4][2], B0[2][2], B1[2][2];
    const char* cA = (const char*)g.A + (size_t)cur.pm * tstep; const char* cB = (const char*)g.Bt + (size_t)cur.pn * tstep;
    S.a_ready(cur);
    if constexpr (SP2) {
        PG8_STAGE(PG8_SB(0, 0), cB, voffB); PG8_STAGE(PG8_SB(0, 1), cB + hstep, voffB); PG8_STAGE(PG8_SA(0, 0), cA, voffA); PG8_STAGE(PG8_SA(0, 1), cA + hstep, voffA);
        if (wr == 1) PG8_BAR;
        PG8_WAIT_V(2); PG8_BAR;
        PG8_STAGE(PG8_SB(1, 0), cB + kstep, voffB); PG8_STAGE(PG8_SA(1, 0), cA + kstep, voffA); PG8_STAGE(PG8_SB(1, 1), cB + hstep + kstep, voffB);
        PG8_WAIT_V(6); PG8_BAR;
    } else {
        PG8_STAGE(PG8_SB(0, 0), cB, voffB); PG8_STAGE(PG8_SA(0, 0), cA, voffA); PG8_STAGE(PG8_SB(0, 1), cB + hstep, voffB); PG8_STAGE(PG8_SA(0, 1), cA + hstep, voffA);
        if (wr == 1) PG8_BAR;
        PG8_WAIT_V(4); PG8_BAR;
        PG8_STAGE(PG8_SB(1, 0), cB + kstep, voffB); PG8_STAGE(PG8_SA(1, 0), cA + kstep, voffA); PG8_STAGE(PG8_SB(1, 1), cB + hstep + kstep, voffB);
        PG8_WAIT_V(6); PG8_BAR;
    }
    for (;;) {
        const bool has_next = S.next(ui + 1, nxt);
        const char* nA = has_next ? (const char*)g.A + (size_t)nxt.pm * tstep : cA; const char* nB = has_next ? (const char*)g.Bt + (size_t)nxt.pn * tstep : cB;
        for (int t = 0; t < nt; t += 2) {
            const bool last = (t == nt - 2);
            const char* a1 = cA + (size_t)(t + 1) * kstep;
            const char* a2 = last ? nA : cA + (size_t)(t + 2) * kstep; const char* b2 = last ? nB : cB + (size_t)(t + 2) * kstep;
            const char* a3 = a2 + kstep; const char* b3 = b2 + kstep;
            if (last && has_next) S.a_ready(nxt);
            if constexpr (SP2) {
            PG8_LDB(B0, 0, 0); PG8_LDB(B1, 0, 1); PG8_SCHED; PG8_LDA(At, 0, 0); PG8_STAGE(PG8_SA(1, 1), a1 + hstep, voffA);
            PG8_WAIT_V(8); PG8_WAIT_L(0); PG8_BAR; PG8_MMA(0, 0, At, B0); PG8_MMA(0, 1, At, B1); PG8_BAR; PG8_SCHED;
            PG8_LDA(At, 0, 1); PG8_STAGE(PG8_SB(0, 0), b2, voffB); PG8_STAGE(PG8_SB(0, 1), b2 + hstep, voffB); PG8_STAGE(PG8_SA(0, 0), a2, voffA);
            PG8_WAIT_V(8); PG8_WAIT_L(0); PG8_BAR; PG8_MMA(1, 0, At, B0); PG8_MMA(1, 1, At, B1); PG8_BAR; PG8_SCHED;
            PG8_LDB(B0, 1, 0); PG8_LDB(B1, 1, 1); PG8_SCHED; PG8_LDA(At, 1, 0); PG8_STAGE(PG8_SA(0, 1), a2 + hstep, voffA);
            PG8_WAIT_V(8); PG8_WAIT_L(0); PG8_BAR; PG8_MMA(0, 0, At, B0); PG8_MMA(0, 1, At, B1); PG8_BAR; PG8_SCHED;
            PG8_LDA(At, 1, 1); PG8_STAGE(PG8_SB(1, 0), b3, voffB); PG8_STAGE(PG8_SB(1, 1), b3 + hstep, voffB); PG8_STAGE(PG8_SA(1, 0), a3, voffA);
            PG8_WAIT_V(8); PG8_WAIT_L(0); PG8_BAR; PG8_MMA(1, 0, At, B0); PG8_MMA(1, 1, At, B1); PG8_BAR; PG8_SCHED;
            } else {
            PG8_LDB(B0, 0, 0); PG8_SCHED; PG8_LDA(At, 0, 0); PG8_STAGE(PG8_SA(1, 1), a1 + hstep, voffA);
            PG8_WAIT_L(8); PG8_BAR; PG8_WAIT_L(0); PG8_MMA(0, 0, At, B0); PG8_BAR; PG8_SCHED;
            PG8_LDB(B1, 0, 1); PG8_STAGE(PG8_SB(0, 0), b2, voffB);
            PG8_BAR; PG8_WAIT_L(0); PG8_MMA(0, 1, At, B1); PG8_BAR;
            PG8_LDA(At, 0, 1); PG8_STAGE(PG8_SA(0, 0), a2, voffA);
            PG8_BAR; PG8_WAIT_L(0); PG8_MMA(1, 0, At, B0); PG8_BAR; PG8_SCHED;
            PG8_STAGE(PG8_SB(0, 1), b2 + hstep, voffB);
            PG8_WAIT_V(6); PG8_BAR; PG8_MMA(1, 1, At, B1); PG8_BAR;
            PG8_LDB(B0, 1, 0); PG8_SCHED; PG8_LDA(At, 1, 0); PG8_STAGE(PG8_SA(0, 1), a2 + hstep, voffA);
            PG8_WAIT_L(8); PG8_BAR; PG8_WAIT_L(0); PG8_MMA(0, 0, At, B0); PG8_BAR; PG8_SCHED;
            PG8_LDB(B1, 1, 1); PG8_STAGE(PG8_SB(1, 0), b3, voffB);
            PG8_BAR; PG8_WAIT_L(0); PG8_MMA(0, 1, At, B1); PG8_BAR;
            PG8_LDA(At, 1, 1); PG8_STAGE(PG8_SA(1, 0), a3, voffA);
            PG8_BAR; PG8_WAIT_L(0); PG8_MMA(1, 0, At, B0); PG8_BAR; PG8_SCHED;
            PG8_STAGE(PG8_SB(1, 1), b3 + hstep, voffB);
            PG8_WAIT_V(6); PG8_BAR; PG8_MMA(1, 1, At, B1); PG8_BAR;
            }
        }
        if constexpr (ALIGN_EPI) { if (wr == 0) PG8_BAR; }
        if constexpr (!Epi::AFTER_DRAIN) { E(acc, cur, wr, wc, fr, fq); S.done(cur); }
        if (!has_next) break;
#pragma unroll
        for (int a = 0; a < 2; ++a)
#pragma unroll
            for (int b = 0; b < 2; ++b)
#pragma unroll
                for (int m = 0; m < 4; ++m)
#pragma unroll
                    for (int n = 0; n < 2; ++n) acc[a][b][m][n] = (f32x4){0.f, 0.f, 0.f, 0.f};
        cur = nxt; cA = nA; cB = nB; ++ui;
        if constexpr (ALIGN_EPI) { if (wr == 1) PG8_BAR; }
    }
    PG8_WAIT_V(0);
    if constexpr (!ALIGN_EPI) { if (wr == 0) PG8_BAR; }
    PG8_BAR;
    if constexpr (Epi::AFTER_DRAIN) { E.fused(acc, cur, wr, wc, fr, fq, lds, wid, lane); S.done(cur); }
#undef PG8_SA
#undef PG8_SB
#undef PG8_STAGE
#undef PG8_LDA
#undef PG8_LDB
#undef PG8_MMA
#undef PG8_WAIT_V
#undef PG8_WAIT_L
#undef PG8_BAR
#undef PG8_SCHED
}
}

__device__ __forceinline__ void transpose_item(const float* Wsrc, int ldsrc, const float* gain, float scale, bf16* dst, int lddst, LAS float* scr, int lane) {
#pragma unroll 8
    for (int i = 0; i < 32; ++i) { const int kk = 2 * i + (lane >> 5); const float gsc = gain ? gain[kk] * scale : scale; scr[kk * 33 + (lane & 31)] = Wsrc[(size_t)kk * ldsrc + (lane & 31)] * gsc; }
    asm volatile("s_waitcnt lgkmcnt(0)" ::: "memory");
    const int c = lane & 7;
#pragma unroll
    for (int j = 0; j < 4; ++j) { const int n = (lane >> 3) + 8 * j; const LAS float* s = scr + (8 * c) * 33 + n;
        u32x4 o; o.x = pk2(s[0 * 33], s[1 * 33]); o.y = pk2(s[2 * 33], s[3 * 33]); o.z = pk2(s[4 * 33], s[5 * 33]); o.w = pk2(s[6 * 33], s[7 * 33]);
        *(u32x4*)(dst + (size_t)n * lddst + 8 * c) = o; }
    asm volatile("s_waitcnt lgkmcnt(0)" ::: "memory");
}
__device__ __forceinline__ int t5_bucket(int d) {
    if (d < 16) return d;
    int v = 16 + (int)(log((double)d / 16.0) / log(128.0) * 16.0);
    return v < 31 ? v : 31;
}
struct In {
    const float *xp, *xs, *state, *c1, *c2, *c3, *norm_g, *w_in, *w_a2, *b_a, *gon, *w_o_a, *g_kv, *w_kv, *w_q, *w_o_b, *rel_bias, *w_gu, *w_down;
};
__device__ __forceinline__ void p0_prologue(LAS unsigned char* lds, const In& I, unsigned char* ws, float* out, int vcu, int G, int tid) {
    const int lane = tid & 63, wave = tid >> 6;
    LAS float* wa = (LAS float*)lds;
    LAS float* scr = (LAS float*)(lds + 65536 + wave * 8448);
    for (int i = tid; i < 1024 * 16; i += 512) { const int k = i >> 4, r = i & 15; wa[i] = I.w_in[(size_t)k * NIN + NWIN + r] * I.norm_g[k]; }
    __syncthreads();
    const int gw = vcu * NWAVES + wave, NGW = G * NWAVES;
    constexpr int I_WIN = 16 * 96, I_WO = 16 * 32, I_GU = 16 * 176, I_WD = 44 * 32, I_KVQ = 16 * 144;
    constexpr int NITEMS = I_WIN + I_WO + 2 * I_GU + 2 * I_WD + I_KVQ + I_WO;
    for (int it = gw; it < NITEMS; it += NGW) {
        int r = it;
        if (r < I_WIN) { const int kb = r / 96, nb = r % 96, k0 = kb * 64, n0 = nb * 32;
            transpose_item(I.w_in + (size_t)k0 * NIN + n0, NIN, I.norm_g + k0, n0 < 512 ? 0.08838834764831845f : 1.f, (bf16*)(ws + WS_WIN) + (size_t)n0 * 1024 + k0, 1024, scr, lane); continue; }
        r -= I_WIN;
        if (r < I_WO) { const int kb = r / 32, nb = r % 32, k0 = kb * 64, n0 = nb * 32;
            transpose_item(I.w_o_a + (size_t)k0 * 1024 + n0, 1024, nullptr, 1.f, (bf16*)(ws + WS_WOA) + (size_t)n0 * 1024 + k0, 1024, scr, lane); continue; }
        r -= I_WO;
        if (r < 2 * I_GU) { const int l = r / I_GU; r -= l * I_GU; const int kb = r / 176, nb = r % 176, k0 = kb * 64, n0 = nb * 32;
            const int tile = n0 >> 8, j = n0 & 255, src = j < 128 ? tile * 128 + j : FF + tile * 128 + (j - 128);
            transpose_item(I.w_gu + (size_t)l * 1024 * NGU + (size_t)k0 * NGU + src, NGU, I.norm_g + (l * 4 + 2) * 1024 + k0, 1.f, (bf16*)(ws + (l ? WS_WGU1 : WS_WGU0)) + (size_t)n0 * 1024 + k0, 1024, scr, lane); continue; }
        r -= 2 * I_GU;
        if (r < 2 * I_WD) { const int l = r / I_WD; r -= l * I_WD; const int kb = r / 32, nb = r % 32, k0 = kb * 64, n0 = nb * 32;
            transpose_item(I.w_down + (size_t)l * FF * 1024 + (size_t)k0 * 1024 + n0, 1024, nullptr, 1.f, (bf16*)(ws + (l ? WS_WD1 : WS_WD0)) + (size_t)n0 * FF + k0, FF, scr, lane); continue; }
        r -= 2 * I_WD;
        if (r < I_KVQ) { const int kb = r / 144, nb = r % 144, k0 = kb * 64, n0 = nb * 32;
            if (n0 < NKV) transpose_item(I.w_kv + (size_t)k0 * NKV + n0, NKV, I.g_kv + k0, 1.f, (bf16*)(ws + WS_WKVQ) + (size_t)n0 * 1024 + k0, 1024, scr, lane);
            else transpose_item(I.w_q + (size_t)k0 * NQ + (n0 - NKV), NQ, I.norm_g + 4 * 1024 + k0, 0.125f, (bf16*)(ws + WS_WKVQ) + (size_t)n0 * 1024 + k0, 1024, scr, lane);
            continue; }
        r -= I_KVQ;
        { const int kb = r / 32, nb = r % 32, k0 = kb * 64, n0 = nb * 32;
            transpose_item(I.w_o_b + (size_t)k0 * 1024 + n0, 1024, nullptr, 1.f, (bf16*)(ws + WS_WOB) + (size_t)n0 * 1024 + k0, 1024, scr, lane); }
    }
    bf16* XB0 = (bf16*)(ws + WS_XB0); float* Abuf = (float*)(ws + WS_ABUF);
    for (int row = gw; row < MT; row += NGW) {
        const float* xr = row < NP ? I.xp + (size_t)row * D : I.xs + (size_t)(row - NP) * D;
        f32x4 v[4]; float ss = 0.f;
#pragma unroll
        for (int j = 0; j < 4; ++j) { v[j] = *(const f32x4*)(xr + 4 * lane + 256 * j); ss += (v[j][0] * v[j][0] + v[j][1] * v[j][1]) + (v[j][2] * v[j][2] + v[j][3] * v[j][3]); }
        const float rstd = rsqrtf(wave_sum(ss) * (1.f / D) + EPS);
        float a[16];
#pragma unroll
        for (int r = 0; r < 16; ++r) a[r] = 0.f;
#pragma unroll
        for (int j = 0; j < 4; ++j) { u32x2 o; o.x = pk2(v[j][0] * rstd, v[j][1] * rstd); o.y = pk2(v[j][2] * rstd, v[j][3] * rstd);
            *(u32x2*)(XB0 + (size_t)row * D + 4 * lane + 256 * j) = o; }
#pragma unroll 1
        for (int j = 0; j < 4; ++j) { const f32x4 xv = *(const f32x4*)(xr + 4 * lane + 256 * j);
#pragma unroll
            for (int i = 0; i < 4; ++i) { const LAS f32x4* w4 = (const LAS f32x4*)(wa + (4 * lane + 256 * j + i) * 16);
#pragma unroll
                for (int q = 0; q < 4; ++q) { const f32x4 w = w4[q]; a[4 * q + 0] += xv[i] * w[0]; a[4 * q + 1] += xv[i] * w[1]; a[4 * q + 2] += xv[i] * w[2]; a[4 * q + 3] += xv[i] * w[3]; } } }
        float mine = 0.f;
#pragma unroll
        for (int r = 0; r < 16; ++r) { const float s = wave_sum(a[r]) * rstd; if (lane == r) mine = s; }
        if (lane < 16) Abuf[(size_t)row * 16 + lane] = mine;
    }
    {
        const size_t gt = (size_t)vcu * 512 + tid, GT = (size_t)G * 512;
#pragma unroll
        for (int g = 0; g < 3; ++g) {
            const int Wg = g == 0 ? 128 : (g == 1 ? 512 : 2048); const float* src = g == 0 ? I.c1 : (g == 1 ? I.c2 : I.c3);
            float* dst = out + (g == 0 ? OFF_W1S : (g == 1 ? OFF_W2S : OFF_W3S));
            const size_t per_b = (size_t)(Wg - 8) * 128;
            const size_t total = per_b * SB;
            for (size_t i = gt; i < total; i += GT) { const size_t b = i / per_b, o = i - b * per_b;
                ((f32x4*)dst)[b * (size_t)Wg * 128 + o] = ((const f32x4*)src)[b * (size_t)Wg * 128 + 8 * 128 + o]; }
        }
    }
    { float* bt = (float*)(ws + WS_BIAS);
      for (int i = vcu * 512 + tid; i < 3 * 16 * NKEYS; i += G * 512) { const int g = i / (16 * NKEYS), hd = (i / NKEYS) % 16, j = i % NKEYS; const int dil = g == 0 ? 1 : (g == 1 ? 4 : 16);
          bt[i] = I.rel_bias[t5_bucket(dil * j) * 48 + g * 16 + hd]; } }
}

__device__ __forceinline__ void rownorm_phase(const float* Y, const float* hp_prompt, const float* hp_sample, const float* gain, float* H, bf16* XB, int vcu, int G, int tid) {
    const int lane = tid & 63, wave = tid >> 6; const int gw = vcu * NWAVES + wave, NGW = G * NWAVES;
    f32x4 gv[4];
#pragma unroll
    for (int j = 0; j < 4; ++j) gv[j] = *(const f32x4*)(gain + 4 * lane + 256 * j);
    for (int row = gw; row < MT; row += NGW) {
        const float* yr = Y + (size_t)row * D; const float* hr = row < NP ? hp_prompt + (size_t)row * D : hp_sample + (size_t)(row - NP) * D;
        f32x4 y[4], h[4]; float ss = 0.f;
#pragma unroll
        for (int j = 0; j < 4; ++j) { y[j] = *(const f32x4*)(yr + 4 * lane + 256 * j); h[j] = *(const f32x4*)(hr + 4 * lane + 256 * j); ss += (y[j][0] * y[j][0] + y[j][1] * y[j][1]) + (y[j][2] * y[j][2] + y[j][3] * y[j][3]); }
        const float rstd = rsqrtf(wave_sum(ss) * (1.f / D) + EPS); float s2 = 0.f;
#pragma unroll
        for (int j = 0; j < 4; ++j) { h[j] = h[j] + y[j] * rstd * gv[j]; *(f32x4*)(H + (size_t)row * D + 4 * lane + 256 * j) = h[j]; s2 += (h[j][0] * h[j][0] + h[j][1] * h[j][1]) + (h[j][2] * h[j][2] + h[j][3] * h[j][3]); }
        if (XB) { const float r2 = rsqrtf(wave_sum(s2) * (1.f / D) + EPS);
#pragma unroll
            for (int j = 0; j < 4; ++j) { u32x2 o; o.x = pk2(h[j][0] * r2, h[j][1] * r2); o.y = pk2(h[j][2] * r2, h[j][3] * r2); *(u32x2*)(XB + (size_t)row * D + 4 * lane + 256 * j) = o; } }
    }
}

__device__ __forceinline__ void gla_simple_phase(LAS unsigned char* lds, const bf16* P, const float* Abuf, const In& I, float* out, bf16* XB, int vcu, int G, int tid) {
    LAS float* sq = (LAS float*)lds;
    LAS float* sk = sq + 2048;
    LAS float* sg = sk + 2048;
    LAS float* sv = sg + 2048;
    LAS float* sa = sv + 4096;
    LAS float* so = sa + 256;
    LAS float* sw2 = so + 8192;
    const int lane = tid & 63, wave = tid >> 6, e = tid & 255, dh = tid >> 8;
    for (int u = vcu; u < 192; u += G) {
        int b, h, T, row0; const float* S0; float* Sout;
        if (u < 64) { b = u >> 2; h = u & 3; T = PT; row0 = b * PT; S0 = nullptr; Sout = out + OFF_GLAP + (size_t)(b * 4 + h) * 32768; }
        else { const int su = u - 64; b = su >> 2; h = su & 3; T = ST; row0 = NP + b * ST; S0 = I.state + (size_t)(b * 4 + h) * 32768; Sout = out + OFF_GLAS + (size_t)(b * 4 + h) * 32768; }
        __syncthreads();
        for (int i = tid; i < 2048; i += 512) sw2[i] = I.w_a2[(i >> 7) * 512 + h * 128 + (i & 127)];
        if (tid < 128) sw2[2048 + tid] = I.b_a[h * 128 + tid];
        float S[64];
#pragma unroll
        for (int i = 0; i < 64; ++i) S[i] = S0 ? S0[(size_t)(64 * dh + i) * 256 + e] : 0.f;
        for (int t0 = 0; t0 < T; t0 += 16) {
            const int nb = (T - t0) < 16 ? (T - t0) : 16;
            __syncthreads();
            if (tid < 256) { const int tt = tid >> 4; sa[tid] = tt < nb ? Abuf[(size_t)(row0 + t0 + tt) * 16 + (tid & 15)] : 0.f; }
            __syncthreads();
            for (int idx = tid; idx < 2048; idx += 512) { const int tt = idx >> 7, d = idx & 127;
                if (tt < nb) { float x = sw2[2048 + d];
#pragma unroll
                    for (int r = 0; r < 16; ++r) x += sa[tt * 16 + r] * sw2[r * 128 + d];
                    const float ls = fminf(x, 0.f) - log1pf(expf(-fabsf(x)));
                    sg[idx] = expf(ls * (1.f / 16.f));
                    const bf16* pr = P + (size_t)(row0 + t0 + tt) * NWIN;
                    sq[idx] = bf2f(pr[h * 128 + d]); sk[idx] = bf2f(pr[512 + h * 128 + d]); } }
            for (int idx = tid; idx < 4096; idx += 512) { const int tt = idx >> 8, ee = idx & 255; if (tt < nb) sv[idx] = bf2f(P[(size_t)(row0 + t0 + tt) * NWIN + 1024 + h * 256 + ee]); }
            __syncthreads();
            for (int tt = 0; tt < nb; ++tt) {
                const float ve = sv[tt * 256 + e]; float acc = 0.f;
                const LAS f32x4* g4 = (const LAS f32x4*)(sg + tt * 128 + 64 * dh); const LAS f32x4* k4 = (const LAS f32x4*)(sk + tt * 128 + 64 * dh); const LAS f32x4* q4 = (const LAS f32x4*)(sq + tt * 128 + 64 * dh);
#pragma unroll
                for (int i4 = 0; i4 < 16; ++i4) { const f32x4 gg = g4[i4], kk = k4[i4], qq = q4[i4];
#pragma unroll
                    for (int c = 0; c < 4; ++c) { S[4 * i4 + c] = S[4 * i4 + c] * gg[c] + kk[c] * ve; acc += qq[c] * S[4 * i4 + c]; } }
                so[(tt * 2 + dh) * 256 + e] = acc;
            }
            __syncthreads();
            for (int tt = wave; tt < nb; tt += 8) {
                const int e0 = lane * 4; const f32x4 o0 = *(const LAS f32x4*)(so + (tt * 2 + 0) * 256 + e0), o1 = *(const LAS f32x4*)(so + (tt * 2 + 1) * 256 + e0);
                const f32x4 o = o0 + o1; const float ss = wave_sum((o[0] * o[0] + o[1] * o[1]) + (o[2] * o[2] + o[3] * o[3])); const float rstd = rsqrtf(ss * (1.f / 256.f) + EPS);
                const size_t row = (size_t)(row0 + t0 + tt); const u32x2 rr = *(const u32x2*)(P + row * NWIN + 2048 + h * 256 + e0); const f32x4 gn = *(const f32x4*)(I.gon + e0);
                const float r0 = bflo(rr.x), r1 = bfhi(rr.x), r2 = bflo(rr.y), r3 = bfhi(rr.y);
                u32x2 w; w.x = pk2(o[0] * rstd * gn[0] * silu_f(r0), o[1] * rstd * gn[1] * silu_f(r1)); w.y = pk2(o[2] * rstd * gn[2] * silu_f(r2), o[3] * rstd * gn[3] * silu_f(r3));
                *(u32x2*)(XB + row * D + h * 256 + e0) = w;
            }
        }
#pragma unroll
        for (int i = 0; i < 64; ++i) Sout[(size_t)(64 * dh + i) * 256 + e] = S[i];
    }
}

__device__ __forceinline__ void attn_simple_phase(LAS unsigned char* lds, const bf16* Qb, const bf16* KV, const In& I, const float* biasT, bf16* XB, int vcu, int G, int tid) {
    const int lane = tid & 63, wave = tid >> 6; const int gw = vcu * NWAVES + wave, NGW = G * NWAVES;
    LAS float* sqw = (LAS float*)(lds + wave * 10240);
    LAS float* sp = sqw + 256;
    for (int task = gw; task < MT * 4; task += NGW) {
        const int row = task >> 2, kvh = task & 3; const bool prompt = row < NP;
        const int b = prompt ? (row >> 11) : ((row - NP) >> 3), t = prompt ? (row & 2047) : ((row - NP) & 7);
#pragma unroll
        for (int g = 0; g < 3; ++g) {
            const int dil = g == 0 ? 1 : (g == 1 ? 4 : 16), Wg = g == 0 ? 128 : (g == 1 ? 512 : 2048); const float* cache = g == 0 ? I.c1 : (g == 1 ? I.c2 : I.c3);
            asm volatile("s_waitcnt lgkmcnt(0)" ::: "memory");
#pragma unroll
            for (int i = 0; i < 4; ++i) sqw[lane + 64 * i] = bf2f(Qb[(size_t)row * NQ + g * 1024 + kvh * 256 + lane + 64 * i]);
            asm volatile("s_waitcnt lgkmcnt(0)" ::: "memory");
#pragma unroll 1
            for (int rd = 0; rd < 3; ++rd) {
                const int j = rd * 64 + lane; bool valid = j < NKEYS; const bf16* kb = nullptr; const float* kf = nullptr;
                if (prompt) { const int idx = t - dil * j; valid = valid && idx >= 0; kb = KV + (size_t)(b * PT + (idx < 0 ? 0 : idx)) * NKV + g * 512 + kvh * 64; }
                else { const int idf = Wg + t - dil * j; if (idf >= Wg) kb = KV + (size_t)(NP + b * ST + (idf - Wg)) * NKV + g * 512 + kvh * 64; else kf = cache + ((size_t)(b * Wg + (idf < 0 ? 0 : idf)) * 2) * 256 + kvh * 64; }
                float d0 = 0.f, d1 = 0.f, d2 = 0.f, d3 = 0.f;
                if (valid) {
#pragma unroll 1
                    for (int c = 0; c < 8; ++c) { float kv[8];
                        if (kb) { const u32x4 w = *(const u32x4*)(kb + c * 8); kv[0] = bflo(w.x); kv[1] = bfhi(w.x); kv[2] = bflo(w.y); kv[3] = bfhi(w.y); kv[4] = bflo(w.z); kv[5] = bfhi(w.z); kv[6] = bflo(w.w); kv[7] = bfhi(w.w); }
                        else { const f32x4 w0 = *(const f32x4*)(kf + c * 8), w1 = *(const f32x4*)(kf + c * 8 + 4); kv[0] = w0[0]; kv[1] = w0[1]; kv[2] = w0[2]; kv[3] = w0[3]; kv[4] = w1[0]; kv[5] = w1[1]; kv[6] = w1[2]; kv[7] = w1[3]; }
#pragma unroll
                        for (int i = 0; i < 8; ++i) { d0 += sqw[c * 8 + i] * kv[i]; d1 += sqw[64 + c * 8 + i] * kv[i]; d2 += sqw[128 + c * 8 + i] * kv[i]; d3 += sqw[192 + c * 8 + i] * kv[i]; } }
                }
                const float* bt = biasT + (size_t)(g * 16 + kvh * 4) * NKEYS + (j < NKEYS ? j : 0);
                sp[(0 * 3 + g) * 192 + j] = valid ? d0 + bt[0] : -INFINITY; sp[(1 * 3 + g) * 192 + j] = valid ? d1 + bt[NKEYS] : -INFINITY;
                sp[(2 * 3 + g) * 192 + j] = valid ? d2 + bt[2 * NKEYS] : -INFINITY; sp[(3 * 3 + g) * 192 + j] = valid ? d3 + bt[3 * NKEYS] : -INFINITY;
            }
        }
        asm volatile("s_waitcnt lgkmcnt(0)" ::: "memory");
        float linv[4];
#pragma unroll
        for (int qq = 0; qq < 4; ++qq) {
            float m = -INFINITY;
#pragma unroll 1
            for (int i = 0; i < 9; ++i) m = fmaxf(m, sp[qq * 576 + i * 64 + lane]);
            m = wave_max(m); float l = 0.f;
#pragma unroll 1
            for (int i = 0; i < 9; ++i) { const float p = __expf(sp[qq * 576 + i * 64 + lane] - m); l += p; sp[qq * 576 + i * 64 + lane] = p; }
            linv[qq] = 1.f / wave_sum(l);
        }
        asm volatile("s_waitcnt lgkmcnt(0)" ::: "memory");
        float o0 = 0.f, o1 = 0.f, o2 = 0.f, o3 = 0.f;
#pragma unroll
        for (int g = 0; g < 3; ++g) {
            const int dil = g == 0 ? 1 : (g == 1 ? 4 : 16), Wg = g == 0 ? 128 : (g == 1 ? 512 : 2048); const float* cache = g == 0 ? I.c1 : (g == 1 ? I.c2 : I.c3);
#pragma unroll 2
            for (int j = 0; j < NKEYS; ++j) {
                float v;
                if (prompt) { const int idx = t - dil * j; if (idx < 0) break; v = bf2f(KV[(size_t)(b * PT + idx) * NKV + g * 512 + 256 + kvh * 64 + lane]); }
                else { const int idf = Wg + t - dil * j; if (idf >= Wg) v = bf2f(KV[(size_t)(NP + b * ST + (idf - Wg)) * NKV + g * 512 + 256 + kvh * 64 + lane]); else v = cache[((size_t)(b * Wg + idf) * 2 + 1) * 256 + kvh * 64 + lane]; }
                o0 += sp[(0 * 3 + g) * 192 + j] * v; o1 += sp[(1 * 3 + g) * 192 + j] * v; o2 += sp[(2 * 3 + g) * 192 + j] * v; o3 += sp[(3 * 3 + g) * 192 + j] * v;
            }
        }
        bf16* orow = XB + (size_t)row * D + kvh * 256 + lane;
        orow[0] = (bf16)(pk2(o0 * linv[0], 0.f) & 0xffffu); orow[64] = (bf16)(pk2(o1 * linv[1], 0.f) & 0xffffu); orow[128] = (bf16)(pk2(o2 * linv[2], 0.f) & 0xffffu); orow[192] = (bf16)(pk2(o3 * linv[3], 0.f) & 0xffffu);
    }
}

struct Args { const float* in[19]; float* out; unsigned char* ws; int ph_lo, ph_hi; };
__global__ void __launch_bounds__(NWAVES * 64, 2) fwd(Args a) {
    extern __shared__ __attribute__((aligned(16))) unsigned char lds_raw[];
    LAS unsigned char* lds = (LAS unsigned char*)lds_raw;
    cg::grid_group grid = cg::this_grid();
    const int tid = threadIdx.x, G = gridDim.x; const int bx = blockIdx.x; const int vcu = (G % 8 == 0) ? (bx % 8) * (G / 8) + bx / 8 : bx;
    In I; I.xp = a.in[0]; I.xs = a.in[1]; I.state = a.in[2]; I.c1 = a.in[3]; I.c2 = a.in[4]; I.c3 = a.in[5]; I.norm_g = a.in[6]; I.w_in = a.in[7]; I.w_a2 = a.in[8]; I.b_a = a.in[9]; I.gon = a.in[10];
    I.w_o_a = a.in[11]; I.g_kv = a.in[12]; I.w_kv = a.in[13]; I.w_q = a.in[14]; I.w_o_b = a.in[15]; I.rel_bias = a.in[16]; I.w_gu = a.in[17]; I.w_down = a.in[18];
    unsigned char* ws = a.ws; float* out = a.out;
    bf16* XB0 = (bf16*)(ws + WS_XB0); bf16* XB1 = (bf16*)(ws + WS_XB1); bf16* BIG = (bf16*)(ws + WS_BIG); float* Y = (float*)(ws + WS_YKV); bf16* KVb = (bf16*)(ws + WS_YKV);
    float* Abuf = (float*)(ws + WS_ABUF); float* biasT = (float*)(ws + WS_BIAS); float* H = out;
    const int lo = a.ph_lo, hi = a.ph_hi;
#define IN(k) (lo <= (k) && (k) < hi)
#define SEAM(k) do { if (IN(k) && IN((k) + 1)) grid.sync(); } while (0)

    if (IN(0)) { p0_prologue(lds, I, ws, out, vcu, G, tid); } SEAM(0);
    if (IN(1)) { pg8::Gemm g{XB0, (const bf16*)(ws + WS_WIN), MT, NWIN, D}; pg8::StaticOrder S; S.init(MT, NWIN, G, bx); pg8::EpiBf16 E{BIG, NWIN};
                 pg8::gemm_phase<pg8::EpiBf16, pg8::StaticOrder, true, true>(lds, g, S, E); } SEAM(1);
    if (IN(2)) { gla_simple_phase(lds, BIG, Abuf, I, out, XB0, vcu, G, tid); } SEAM(2);
    if (IN(3)) { pg8::Gemm g{XB0, (const bf16*)(ws + WS_WOA), MT, D, D}; pg8::StaticOrder S; S.init(MT, D, G, bx); pg8::EpiF32 E{Y, D};
                 pg8::gemm_phase<pg8::EpiF32, pg8::StaticOrder, true, true>(lds, g, S, E); } SEAM(3);
    if (IN(4)) { rownorm_phase(Y, I.xp, I.xs, I.norm_g + 1 * 1024, H, XB1, vcu, G, tid); } SEAM(4);
    if (IN(5)) { pg8::Gemm g{XB1, (const bf16*)(ws + WS_WGU0), MT, NGU, D}; pg8::StaticOrder S; S.init(MT, NGU, G, bx); pg8::EpiSwiGLU E{BIG, FF};
                 pg8::gemm_phase<pg8::EpiSwiGLU, pg8::StaticOrder, true, true>(lds, g, S, E); } SEAM(5);
    if (IN(6)) { pg8::Gemm g{BIG, (const bf16*)(ws + WS_WD0), MT, D, FF}; pg8::StaticOrder S; S.init(MT, D, G, bx); pg8::EpiF32 E{Y, D};
                 pg8::gemm_phase<pg8::EpiF32, pg8::StaticOrder, true, true>(lds, g, S, E); } SEAM(6);
    if (IN(7)) { rownorm_phase(Y, H, H + (size_t)NP * D, I.norm_g + 3 * 1024, H, XB0, vcu, G, tid); } SEAM(7);
    if (IN(8)) { pg8::Gemm g{XB0, (const bf16*)(ws + WS_WKVQ), MT, NKVQ, D}; pg8::StaticOrder S; S.init(MT, NKVQ, G, bx); pg8::EpiKVQ E{KVb, BIG, out};
                 pg8::gemm_phase<pg8::EpiKVQ, pg8::StaticOrder, true, true>(lds, g, S, E); } SEAM(8);
    if (IN(9)) { attn_simple_phase(lds, BIG, KVb, I, biasT, XB1, vcu, G, tid); } SEAM(9);
    if (IN(10)) { pg8::Gemm g{XB1, (const bf16*)(ws + WS_WOB), MT, D, D}; pg8::StaticOrder S; S.init(MT, D, G, bx); pg8::EpiF32 E{Y, D};
                  pg8::gemm_phase<pg8::EpiF32, pg8::StaticOrder, true, true>(lds, g, S, E); } SEAM(10);
    if (IN(11)) { rownorm_phase(Y, H, H + (size_t)NP * D, I.norm_g + 5 * 1024, H, XB0, vcu, G, tid); } SEAM(11);
    if (IN(12)) { pg8::Gemm g{XB0, (const bf16*)(ws + WS_WGU1), MT, NGU, D}; pg8::StaticOrder S; S.init(MT, NGU, G, bx); pg8::EpiSwiGLU E{BIG, FF};
                  pg8::gemm_phase<pg8::EpiSwiGLU, pg8::StaticOrder, true, true>(lds, g, S, E); } SEAM(12);
    if (IN(13)) { pg8::Gemm g{BIG, (const bf16*)(ws + WS_WD1), MT, D, FF}; pg8::StaticOrder S; S.init(MT, D, G, bx); pg8::EpiF32 E{Y, D};
                  pg8::gemm_phase<pg8::EpiF32, pg8::StaticOrder, true, true>(lds, g, S, E); } SEAM(13);
    if (IN(14)) { rownorm_phase(Y, H, H + (size_t)NP * D, I.norm_g + 7 * 1024, H, nullptr, vcu, G, tid); }
#undef IN
#undef SEAM
}

#ifndef ONE_LAUNCH
#define ONE_LAUNCH 1
#endif
extern "C" void kernel_launch(void* const* d_in, const int* in_sizes, int n_in, void* d_out, int out_size, void* d_ws, size_t ws_size, hipStream_t stream) {
    static int grid = 0;
    if (grid == 0) {
        if (n_in != 19 || (size_t)out_size != OUT_TOTAL || ws_size < WS_END) { fprintf(stderr, "kernel_launch: unexpected shapes: n_in %d out %d ws %zu (need %zu)\n", n_in, out_size, ws_size, (size_t)WS_END); grid = -1; return; }
        int dev = 0, cus = 0, per_cu = 0;
        if (hipGetDevice(&dev) != hipSuccess || hipDeviceGetAttribute(&cus, hipDeviceAttributeMultiprocessorCount, dev) != hipSuccess) { grid = -1; return; }
        if (hipFuncSetAttribute((const void*)fwd, hipFuncAttributeMaxDynamicSharedMemorySize, LDS_BYTES) != hipSuccess) { fprintf(stderr, "kernel_launch: hipFuncSetAttribute failed\n"); grid = -1; return; }
        if (hipOccupancyMaxActiveBlocksPerMultiprocessor(&per_cu, (const void*)fwd, NWAVES * 64, LDS_BYTES) != hipSuccess || per_cu < 1) { fprintf(stderr, "kernel_launch: occupancy query says %d blocks per CU\n", per_cu); (void)hipGetLastError(); per_cu = 1; }
        grid = cus;
        if (grid > 256) grid = 256;
    }
    if (grid < 0) return;
    Args a{};
    for (int i = 0; i < 19; ++i) a.in[i] = (const float*)d_in[i];
    a.out = (float*)d_out; a.ws = (unsigned char*)d_ws;
#if ONE_LAUNCH
    a.ph_lo = 0; a.ph_hi = NPHASE;
    void* args[] = {&a};
    hipError_t e = hipLaunchCooperativeKernel((const void*)fwd, dim3(grid), dim3(NWAVES * 64), args, LDS_BYTES, stream);
    if (e != hipSuccess) fprintf(stderr, "cooperative launch failed: %s (grid %d)\n", hipGetErrorString(e), grid);
#else
    for (int ph = 0; ph < NPHASE; ++ph) { a.ph_lo = ph; a.ph_hi = ph + 1; hipLaunchKernelGGL(fwd, dim3(grid), dim3(NWAVES * 64), LDS_BYTES, stream, a); }
#endif
}
```

```cpp
#include <hip/hip_runtime.h>
#include <hip/hip_cooperative_groups.h>
#include <cstdio>
#include <cstdint>
namespace cg = cooperative_groups;
#ifndef GEMM_REP
#define GEMM_REP 1
#endif

constexpr int D = 1024, PB = 16, PT = 2048, SB = 32, ST = 8, PAST = 16384;
constexpr int NP = PB * PT;
constexpr int NS = SB * ST;
constexpr int MT = NP + NS;
constexpr int GH = 4, GDK = 128, GDV = 256, RANK = 16;
constexpr int NIN = 3088;
constexpr int NWIN = 3072;
constexpr int FF = 2816, NGU = 2 * FF;
constexpr int NKV = 1536, NQ = 3072, NKVQ = NKV + NQ;
constexpr int NKEYS = 129;
constexpr float EPS = 1e-6f;
constexpr size_t OFF_YP = 0, OFF_YS = 33554432, OFF_GLAP = 33816576, OFF_W1P = 35913728, OFF_W2P = 36962304, OFF_W3P = 41156608,
                 OFF_GLAS = 57933824, OFF_W1S = 62128128, OFF_W2S = 64225280, OFF_W3S = 72613888, OUT_TOTAL = 106168320;
constexpr size_t MiB = 1u << 20;
constexpr size_t WS_CTL = 0;
constexpr size_t WS_WIN = 1 * MiB;
constexpr size_t WS_WOA = WS_WIN + 6 * MiB;
constexpr size_t WS_WGU0 = WS_WOA + 2 * MiB;
constexpr size_t WS_WD0 = WS_WGU0 + 11 * MiB;
constexpr size_t WS_WKVQ = WS_WD0 + 11 * MiB / 2;
constexpr size_t WS_WOB = WS_WKVQ + 9 * MiB;
constexpr size_t WS_WGU1 = WS_WOB + 2 * MiB;
constexpr size_t WS_WD1 = WS_WGU1 + 11 * MiB;
constexpr size_t WS_ABUF = 53 * MiB;
constexpr size_t WS_BIAS = 55 * MiB + 512 * 1024;
constexpr size_t WS_XB0 = 56 * MiB;
constexpr size_t WS_XB1 = 121 * MiB;
constexpr size_t WS_BIG = 186 * MiB;
constexpr size_t WS_YKV = 380 * MiB;
constexpr size_t WS_LST = 480 * MiB;
constexpr size_t WS_END = 509 * MiB;
static_assert(WS_YKV + (size_t)MT * 1536 * 2 <= WS_LST && WS_LST + (size_t)MT * 32 * 4 <= WS_END, "LST");
static_assert(WS_WD1 + 11 * MiB / 2 <= WS_ABUF && WS_ABUF + (size_t)MT * 16 * 4 <= WS_BIAS && WS_XB0 + (size_t)MT * D * 2 <= WS_XB1 &&
              WS_XB1 + (size_t)MT * D * 2 <= WS_BIG && WS_BIG + (size_t)MT * 3072 * 2 <= WS_YKV && WS_YKV + (size_t)MT * D * 4 <= WS_END, "d_ws map");

constexpr int LDS_BYTES = 147456;
constexpr int NWAVES = 8;
constexpr int NPHASE = 15;

#define LAS __attribute__((address_space(3)))
typedef unsigned short bf16;
typedef float f32x4 __attribute__((ext_vector_type(4)));
typedef float f32x2 __attribute__((ext_vector_type(2)));
typedef unsigned u32x4 __attribute__((ext_vector_type(4)));
typedef unsigned u32x2 __attribute__((ext_vector_type(2)));
typedef __bf16 bf16x2_t __attribute__((ext_vector_type(2)));
__device__ __forceinline__ unsigned pk2(float lo, float hi) { f32x2 v = {lo, hi}; bf16x2_t b = __builtin_convertvector(v, bf16x2_t); return __builtin_bit_cast(unsigned, b); }
__device__ __forceinline__ float bf2f(unsigned short h) { return __uint_as_float((unsigned)h << 16); }
__device__ __forceinline__ float bflo(unsigned w) { return __uint_as_float(w << 16); }
__device__ __forceinline__ float bfhi(unsigned w) { return __uint_as_float(w & 0xffff0000u); }
__device__ __forceinline__ float wave_sum(float v) {
#pragma unroll
    for (int o = 1; o < 64; o <<= 1) v += __shfl_xor(v, o);
    return v;
}
__device__ __forceinline__ float wave_max(float v) {
#pragma unroll
    for (int o = 1; o < 64; o <<= 1) v = fmaxf(v, __shfl_xor(v, o));
    return v;
}
__device__ __forceinline__ float silu_f(float x) { return x * __builtin_amdgcn_rcpf(1.f + __expf(-x)); }

namespace pg8 {
#define PG8_LAS __attribute__((address_space(3)))
typedef unsigned short bf16_t;
typedef short bf16x8 __attribute__((ext_vector_type(8)));
typedef float f32x4 __attribute__((ext_vector_type(4)));
typedef unsigned u32x4 __attribute__((ext_vector_type(4)));
constexpr int BM = 256, BK = 64, HALF = 128, HTB = HALF * BK * 2  , STAGE_BYTES = 8 * HTB, NXCD = 8, WGM = 8;

__host__ __device__ __forceinline__ int lds_byte(int r, int c) { const int st = (r >> 4) * 2 + (c >> 5), rr = r & 15, cc = c & 31, ob = rr * 64 + cc * 2; return st * 1024 + (ob ^ (((ob >> 9) & 1) << 5)); }
__host__ __device__ __forceinline__ void stage_rc(int b, int& R, int& C) { const int st = b / 1024, sb = b % 1024, swz = sb ^ (((sb >> 9) & 1) << 5); R = (st >> 1) * 16 + swz / 64; C = (st & 1) * 32 + (swz % 64) / 2; }
__host__ __device__ __forceinline__ int perm32(int rho) { const int n = rho >> 4, i = rho & 15; return 8 * (i >> 2) + 4 * n + (i & 3); }

struct Unit { int pm, pn; };
struct Gemm { const bf16_t* A; const bf16_t* Bt; int M, N, K; };

struct StaticOrder {
    int nM, nN, nwg, G, c;
    __host__ __device__ void init(int M, int N, int G_, int c_) { nM = M / BM; nN = N / BM; nwg = nM * nN; G = G_; c = c_; }
    __host__ __device__ bool next(int i, Unit& u) const {
#if GEMM_REP > 1
        { const int mine = (nwg - c + G - 1) / G; if (i >= mine * GEMM_REP) return false; i %= mine; }
#endif
        const long L = (long)i * G + c; if (L >= nwg) return false;
        int wgid = (int)L; { const int q = nwg / NXCD, r = nwg % NXCD, xcd = wgid % NXCD, off = wgid / NXCD; wgid = (xcd < r ? xcd * (q + 1) : r * (q + 1) + (xcd - r) * q) + off; }
        const int nig = WGM * nN, gid = wgid / nig, fm = gid * WGM, gsz = (nM - fm) < WGM ? (nM - fm) : WGM;
        u.pm = fm + ((wgid % nig) % gsz); u.pn = (wgid % nig) / gsz; return true;
    }
    __device__ __forceinline__ void a_ready(const Unit&) const {}
    __device__ __forceinline__ void done(const Unit&) const {}
};


__device__ __forceinline__ unsigned epk2(float lo, float hi) { return ::pk2(lo, hi); }
struct EpiBf16 {
    static constexpr bool PERM = true, AFTER_DRAIN = false;
    bf16_t* O; int ldc;
    __device__ __forceinline__ void operator()(const f32x4 (&acc)[2][2][4][2], const Unit& u, int wr, int wc, int fr, int fq) const {
        const int row0 = u.pm * BM + wr * 64 + fr, col0 = u.pn * BM + wc * 32 + 8 * fq;
#pragma unroll
        for (int ai = 0; ai < 2; ++ai)
#pragma unroll
            for (int m = 0; m < 4; ++m) { bf16_t* rowp = O + (size_t)(row0 + ai * HALF + m * 16) * ldc + col0;
#pragma unroll
                for (int bj = 0; bj < 2; ++bj) { const f32x4 v0 = acc[ai][bj][m][0], v1 = acc[ai][bj][m][1];
                    u32x4 w; w.x = epk2(v0[0], v0[1]); w.y = epk2(v0[2], v0[3]); w.z = epk2(v1[0], v1[1]); w.w = epk2(v1[2], v1[3]);
                    *(u32x4*)(rowp + bj * HALF) = w; } }
    }
};
struct EpiF32 {
    static constexpr bool PERM = false, AFTER_DRAIN = false;
    float* C; int ldc;
    __device__ __forceinline__ void operator()(const f32x4 (&acc)[2][2][4][2], const Unit& u, int wr, int wc, int fr, int fq) const {
        const int row0 = u.pm * BM + wr * 64 + fr, col0 = u.pn * BM + wc * 32 + 4 * fq;
#pragma unroll
        for (int ai = 0; ai < 2; ++ai)
#pragma unroll
            for (int m = 0; m < 4; ++m) { float* rowp = C + (size_t)(row0 + ai * HALF + m * 16) * ldc + col0;
#pragma unroll
                for (int bj = 0; bj < 2; ++bj)
#pragma unroll
                    for (int n = 0; n < 2; ++n) *(f32x4*)(rowp + bj * HALF + n * 16) = acc[ai][bj][m][n]; }
    }
};
struct EpiSwiGLU {
    static constexpr bool PERM = true, AFTER_DRAIN = false;
    bf16_t* Hd; int ldh;
    __device__ __forceinline__ void operator()(const f32x4 (&acc)[2][2][4][2], const Unit& u, int wr, int wc, int fr, int fq) const {
        const int row0 = u.pm * BM + wr * 64 + fr, col0 = u.pn * HALF + wc * 32 + 8 * fq;
#pragma unroll
        for (int ai = 0; ai < 2; ++ai)
#pragma unroll
            for (int m = 0; m < 4; ++m) { bf16_t* rowp = Hd + (size_t)(row0 + ai * HALF + m * 16) * ldh + col0;
                const f32x4 g0 = acc[ai][0][m][0], g1 = acc[ai][0][m][1], u0 = acc[ai][1][m][0], u1 = acc[ai][1][m][1];
                float h[8];
#pragma unroll
                for (int i = 0; i < 4; ++i) { h[i] = ::silu_f(g0[i]) * u0[i]; h[4 + i] = ::silu_f(g1[i]) * u1[i]; }
                u32x4 w; w.x = epk2(h[0], h[1]); w.y = epk2(h[2], h[3]); w.z = epk2(h[4], h[5]); w.w = epk2(h[6], h[7]);
                *(u32x4*)rowp = w; }
    }
};
struct EpiKVQ {
    static constexpr bool PERM = true, AFTER_DRAIN = false;
    bf16_t* KV; bf16_t* Q; float* out;
    __device__ __forceinline__ void operator()(const f32x4 (&acc)[2][2][4][2], const Unit& u, int wr, int wc, int fr, int fq) const {
        const int row0 = u.pm * BM + wr * 64 + fr; const int tcol = wc * 32 + 8 * fq;
        const bool iskv = u.pn < 6;
        bf16_t* base = iskv ? KV + u.pn * BM + tcol : Q + (u.pn - 6) * BM + tcol; const int ldc = iskv ? ::NKV : ::NQ;
        const int g = u.pn >> 1, s = u.pn & 1; const int Wg = g == 0 ? 128 : (g == 1 ? 512 : 2048);
        float* wp = out + (g == 0 ? ::OFF_W1P : (g == 1 ? ::OFF_W2P : ::OFF_W3P)); float* wsm = out + (g == 0 ? ::OFF_W1S : (g == 1 ? ::OFF_W2S : ::OFF_W3S));
#pragma unroll
        for (int ai = 0; ai < 2; ++ai)
#pragma unroll
            for (int m = 0; m < 4; ++m) { const int row = row0 + ai * HALF + m * 16; bf16_t* rowp = base + (size_t)row * ldc;
#pragma unroll
                for (int bj = 0; bj < 2; ++bj) { const f32x4 v0 = acc[ai][bj][m][0], v1 = acc[ai][bj][m][1];
                    u32x4 w; w.x = epk2(v0[0], v0[1]); w.y = epk2(v0[2], v0[3]); w.z = epk2(v1[0], v1[1]); w.w = epk2(v1[2], v1[3]);
                    *(u32x4*)(rowp + bj * HALF) = w; }
                if (iskv) {
                    float* dst = nullptr;
                    if (row < ::NP) { const int b = row >> 11, t = row & 2047, tp = t - (2048 - Wg); if (tp >= 0) dst = wp + ((size_t)(b * Wg + tp) * 512 + s * 256 + tcol); }
                    else { const int sr = row - ::NP, b = sr >> 3, r = sr & 7; dst = wsm + ((size_t)(b * Wg + (Wg - 8 + r)) * 512 + s * 256 + tcol); }
                    if (dst) {
#pragma unroll
                        for (int bj = 0; bj < 2; ++bj) { *(f32x4*)(dst + bj * HALF) = acc[ai][bj][m][0]; *(f32x4*)(dst + bj * HALF + 4) = acc[ai][bj][m][1]; } }
                } }
    }
};

template <class Epi, class Sched, bool ALIGN_EPI = false, bool SP2 = false>
__device__ __forceinline__ void gemm_phase(PG8_LAS unsigned char* lds, const Gemm g, const Sched& S, const Epi& E) {
    const int tid = threadIdx.x, wid = __builtin_amdgcn_readfirstlane(tid >> 6), lane = tid & 63, wr = wid >> 2, wc = wid & 3, fr = lane & 15, fq = lane >> 4;
    const int K = g.K, nt = K / BK;
    unsigned voffA[2], voffB[2];
#pragma unroll
    for (int i = 0; i < 2; ++i) { int R, C; stage_rc(tid * 16 + i * 8192, R, C); const int Rb = Epi::PERM ? ((R & ~31) + perm32(R & 31)) : R;
        voffA[i] = (unsigned)(R * K + C) * 2u; voffB[i] = (unsigned)(Rb * K + C) * 2u; }
    const size_t kstep = (size_t)(BK * 2);
    const size_t hstep = (size_t)HALF * K * 2;
    const size_t tstep = 2 * hstep;
    const unsigned ldsw = (unsigned)wid * 1024u;
    const int aoff = lds_byte(wr * 64 + fr, fq * 8), boff = lds_byte(wc * 32 + fr, fq * 8);
#define PG8_SA(b, h) (((b) * 2 + (h)) * HTB)
#define PG8_SB(b, h) ((4 + (b) * 2 + (h)) * HTB)
#define PG8_STAGE(bufoff, gbase, voff) do { _Pragma("unroll") for (int _i = 0; _i < 2; ++_i) \
        __builtin_amdgcn_global_load_lds((const unsigned*)((const char*)(gbase) + (voff)[_i]), (PG8_LAS unsigned*)(lds + (bufoff) + ldsw + _i * 8192), 16, 0, 0); } while (0)
#define PG8_LDA(dst, b, h) do { _Pragma("unroll") for (int m = 0; m < 4; ++m) _Pragma("unroll") for (int k = 0; k < 2; ++k) dst[m][k] = *(const PG8_LAS bf16x8*)(lds + PG8_SA(b, h) + aoff + m * 2048 + k * 1024); } while (0)
#define PG8_LDB(dst, b, h) do { _Pragma("unroll") for (int n = 0; n < 2; ++n) _Pragma("unroll") for (int k = 0; k < 2; ++k) dst[n][k] = *(const PG8_LAS bf16x8*)(lds + PG8_SB(b, h) + boff + n * 2048 + k * 1024); } while (0)
#define PG8_MMA(ai, bj, At, Bt) do { __builtin_amdgcn_s_setprio(1); _Pragma("unroll") for (int m = 0; m < 4; ++m) _Pragma("unroll") for (int n = 0; n < 2; ++n) _Pragma("unroll") for (int k = 0; k < 2; ++k) \
        acc[ai][bj][m][n] = __builtin_amdgcn_mfma_f32_16x16x32_bf16(Bt[n][k], At[m][k], acc[ai][bj][m][n], 0, 0, 0); __builtin_amdgcn_s_setprio(0); } while (0)
#define PG8_WAIT_V(n) asm volatile("s_waitcnt vmcnt(" #n ")" ::: "memory")
#define PG8_WAIT_L(n) asm volatile("s_waitcnt lgkmcnt(" #n ")" ::: "memory")
#define PG8_BAR __builtin_amdgcn_s_barrier()
#define PG8_SCHED __builtin_amdgcn_sched_barrier(0)
    Unit cur, nxt; int ui = 0;
    if (!S.next(0, cur)) return;
    f32x4 acc[2][2][4][2];
#pragma unroll
    for (int a = 0; a < 2; ++a)
#pragma unroll
        for (int b = 0; b < 2; ++b)
#pragma unroll
            for (int m = 0; m < 4; ++m)
#pragma unroll
                for (int n = 0; n < 2; ++n) acc[a][b][m][n] = (f32x4){0.f, 0.f, 0.f, 0.f};
    bf16x8 At[4][2], B0[2][2], B1[2][2];
    const char* cA = (const char*)g.A + (size_t)cur.pm * tstep; const char* cB = (const char*)g.Bt + (size_t)cur.pn * tstep;
    S.a_ready(cur);
    if constexpr (SP2) {
        PG8_STAGE(PG8_SB(0, 0), cB, voffB); PG8_STAGE(PG8_SB(0, 1), cB + hstep, voffB); PG8_STAGE(PG8_SA(0, 0), cA, voffA); PG8_STAGE(PG8_SA(0, 1), cA + hstep, voffA);
        if (wr == 1) PG8_BAR;
        PG8_WAIT_V(2); PG8_BAR;
        PG8_STAGE(PG8_SB(1, 0), cB + kstep, voffB); PG8_STAGE(PG8_SA(1, 0), cA + kstep, voffA); PG8_STAGE(PG8_SB(1, 1), cB + hstep + kstep, voffB);
        PG8_WAIT_V(6); PG8_BAR;
    } else {
        PG8_STAGE(PG8_SB(0, 0), cB, voffB); PG8_STAGE(PG8_SA(0, 0), cA, voffA); PG8_STAGE(PG8_SB(0, 1), cB + hstep, voffB); PG8_STAGE(PG8_SA(0, 1), cA + hstep, voffA);
        if (wr == 1) PG8_BAR;
        PG8_WAIT_V(4); PG8_BAR;
        PG8_STAGE(PG8_SB(1, 0), cB + kstep, voffB); PG8_STAGE(PG8_SA(1, 0), cA + kstep, voffA); PG8_STAGE(PG8_SB(1, 1), cB + hstep + kstep, voffB);
        PG8_WAIT_V(6); PG8_BAR;
    }
    for (;;) {
        const bool has_next = S.next(ui + 1, nxt);
        const char* nA = has_next ? (const char*)g.A + (size_t)nxt.pm * tstep : cA; const char* nB = has_next ? (const char*)g.Bt + (size_t)nxt.pn * tstep : cB;
        for (int t = 0; t < nt; t += 2) {
            const bool last = (t == nt - 2);
            const char* a1 = cA + (size_t)(t + 1) * kstep;
            const char* a2 = last ? nA : cA + (size_t)(t + 2) * kstep; const char* b2 = last ? nB : cB + (size_t)(t + 2) * kstep;
            const char* a3 = a2 + kstep; const char* b3 = b2 + kstep;
            if (last && has_next) S.a_ready(nxt);
            if constexpr (SP2) {
            PG8_LDB(B0, 0, 0); PG8_LDB(B1, 0, 1); PG8_SCHED; PG8_LDA(At, 0, 0); PG8_STAGE(PG8_SA(1, 1), a1 + hstep, voffA);
            PG8_WAIT_V(8); PG8_WAIT_L(0); PG8_BAR; PG8_MMA(0, 0, At, B0); PG8_MMA(0, 1, At, B1); PG8_BAR; PG8_SCHED;
            PG8_LDA(At, 0, 1); PG8_STAGE(PG8_SB(0, 0), b2, voffB); PG8_STAGE(PG8_SB(0, 1), b2 + hstep, voffB); PG8_STAGE(PG8_SA(0, 0), a2, voffA);
            PG8_WAIT_V(8); PG8_WAIT_L(0); PG8_BAR; PG8_MMA(1, 0, At, B0); PG8_MMA(1, 1, At, B1); PG8_BAR; PG8_SCHED;
            PG8_LDB(B0, 1, 0); PG8_LDB(B1, 1, 1); PG8_SCHED; PG8_LDA(At, 1, 0); PG8_STAGE(PG8_SA(0, 1), a2 + hstep, voffA);
            PG8_WAIT_V(8); PG8_WAIT_L(0); PG8_BAR; PG8_MMA(0, 0, At, B0); PG8_MMA(0, 1, At, B1); PG8_BAR; PG8_SCHED;
            PG8_LDA(At, 1, 1); PG8_STAGE(PG8_SB(1, 0), b3, voffB); PG8_STAGE(PG8_SB(1, 1), b3 + hstep, voffB); PG8_STAGE(PG8_SA(1, 0), a3, voffA);
            PG8_WAIT_V(8); PG8_WAIT_L(0); PG8_BAR; PG8_MMA(1, 0, At, B0); PG8_MMA(1, 1, At, B1); PG8_BAR; PG8_SCHED;
            } else {
            PG8_LDB(B0, 0, 0); PG8_SCHED; PG8_LDA(At, 0, 0); PG8_STAGE(PG8_SA(1, 1), a1 + hstep, voffA);
            PG8_WAIT_L(8); PG8_BAR; PG8_WAIT_L(0); PG8_MMA(0, 0, At, B0); PG8_BAR; PG8_SCHED;
            PG8_LDB(B1, 0, 1); PG8_STAGE(PG8_SB(0, 0), b2, voffB);
            PG8_BAR; PG8_WAIT_L(0); PG8_MMA(0, 1, At, B1); PG8_BAR;
            PG8_LDA(At, 0, 1); PG8_STAGE(PG8_SA(0, 0), a2, voffA);
            PG8_BAR; PG8_WAIT_L(0); PG8_MMA(1, 0, At, B0); PG8_BAR; PG8_SCHED;
            PG8_STAGE(PG8_SB(0, 1), b2 + hstep, voffB);
            PG8_WAIT_V(6); PG8_BAR; PG8_MMA(1, 1, At, B1); PG8_BAR;
            PG8_LDB(B0, 1, 0); PG8_SCHED; PG8_LDA(At, 1, 0); PG8_STAGE(PG8_SA(0, 1), a2 + hstep, voffA);
            PG8_WAIT_L(8); PG8_BAR; PG8_WAIT_L(0); PG8_MMA(0, 0, At, B0); PG8_BAR; PG8_SCHED;
            PG8_LDB(B1, 1, 1); PG8_STAGE(PG8_SB(1, 0), b3, voffB);
            PG8_BAR; PG8_WAIT_L(0); PG8_MMA(0, 1, At, B1); PG8_BAR;
            PG8_LDA(At, 1, 1); PG8_STAGE(PG8_SA(1, 0), a3, voffA);
            PG8_BAR; PG8_WAIT_L(0); PG8_MMA(1, 0, At, B0); PG8_BAR; PG8_SCHED;
            PG8_STAGE(PG8_SB(1, 1), b3 + hstep, voffB);
            PG8_WAIT_V(6); PG8_BAR; PG8_MMA(1, 1, At, B1); PG8_BAR;
            }
        }
        if constexpr (ALIGN_EPI) { if (wr == 0) PG8_BAR; }
        if constexpr (!Epi::AFTER_DRAIN) { E(acc, cur, wr, wc, fr, fq); S.done(cur); }
        if (!has_next) break;
#pragma unroll
        for (int a = 0; a < 2; ++a)
#pragma unroll
            for (int b = 0; b < 2; ++b)
#pragma unroll
                for (int m = 0; m < 4; ++m)
#pragma unroll
                    for (int n = 0; n < 2; ++n) acc[a][b][m][n] = (f32x4){0.f, 0.f, 0.f, 0.f};
        cur = nxt; cA = nA; cB = nB; ++ui;
        if constexpr (ALIGN_EPI) { if (wr == 1) PG8_BAR; }
    }
    PG8_WAIT_V(0);
    if constexpr (!ALIGN_EPI) { if (wr == 0) PG8_BAR; }
    PG8_BAR;
    if constexpr (Epi::AFTER_DRAIN) { E.fused(acc, cur, wr, wc, fr, fq, lds, wid, lane); S.done(cur); }
#undef PG8_SA
#undef PG8_SB
#undef PG8_STAGE
#undef PG8_LDA
#undef PG8_LDB
#undef PG8_MMA
#undef PG8_WAIT_V
#undef PG8_WAIT_L
#undef PG8_BAR
#undef PG8_SCHED
}
}
#ifndef GEMM_REP
#define GEMM_REP 1
#endif
#ifndef GLA_REP
#define GLA_REP 1
#endif
#ifndef ATT_REP
#define ATT_REP 1
#endif

__device__ __forceinline__ void transpose_item(const float* Wsrc, int ldsrc, const float* gain, float scale, bf16* dst, int lddst, LAS float* scr, int lane) {
#pragma unroll 8
    for (int i = 0; i < 32; ++i) { const int kk = 2 * i + (lane >> 5); const float gsc = gain ? gain[kk] * scale : scale; scr[kk * 33 + (lane & 31)] = Wsrc[(size_t)kk * ldsrc + (lane & 31)] * gsc; }
    asm volatile("s_waitcnt lgkmcnt(0)" ::: "memory");
    const int c = lane & 7;
#pragma unroll
    for (int j = 0; j < 4; ++j) { const int n = (lane >> 3) + 8 * j; const LAS float* s = scr + (8 * c) * 33 + n;
        u32x4 o; o.x = pk2(s[0 * 33], s[1 * 33]); o.y = pk2(s[2 * 33], s[3 * 33]); o.z = pk2(s[4 * 33], s[5 * 33]); o.w = pk2(s[6 * 33], s[7 * 33]);
        *(u32x4*)(dst + (size_t)n * lddst + 8 * c) = o; }
    asm volatile("s_waitcnt lgkmcnt(0)" ::: "memory");
}
__device__ __forceinline__ int t5_bucket(int d) {
    if (d < 16) return d;
    int v = 16 + (int)(log((double)d / 16.0) / log(128.0) * 16.0);
    return v < 31 ? v : 31;
}
struct In {
    const float *xp, *xs, *state, *c1, *c2, *c3, *norm_g, *w_in, *w_a2, *b_a, *gon, *w_o_a, *g_kv, *w_kv, *w_q, *w_o_b, *rel_bias, *w_gu, *w_down;
};
__device__ __forceinline__ void p0_prologue(LAS unsigned char* lds, const In& I, unsigned char* ws, float* out, int vcu, int G, int tid) {
    const int lane = tid & 63, wave = tid >> 6;
    LAS float* wa = (LAS float*)lds;
    LAS float* scr = (LAS float*)(lds + 65536 + wave * 8448);
    for (int i = tid; i < 1024 * 16; i += 512) { const int k = i >> 4, r = i & 15; wa[i] = I.w_in[(size_t)k * NIN + NWIN + r] * I.norm_g[k]; }
    __syncthreads();
    const int gw = vcu * NWAVES + wave, NGW = G * NWAVES;
    constexpr int I_WIN = 16 * 96, I_WO = 16 * 32, I_GU = 16 * 176, I_WD = 44 * 32, I_KVQ = 16 * 144;
    constexpr int NITEMS = I_WIN + I_WO + 2 * I_GU + 2 * I_WD + I_KVQ + I_WO;
    for (int it = gw; it < NITEMS; it += NGW) {
        int r = it;
        if (r < I_WIN) { const int kb = r / 96, nb = r % 96, k0 = kb * 64, n0 = nb * 32;
            transpose_item(I.w_in + (size_t)k0 * NIN + n0, NIN, I.norm_g + k0, n0 < 512 ? 0.08838834764831845f : 1.f, (bf16*)(ws + WS_WIN) + (size_t)n0 * 1024 + k0, 1024, scr, lane); continue; }
        r -= I_WIN;
        if (r < I_WO) { const int kb = r / 32, nb = r % 32, k0 = kb * 64, n0 = nb * 32;
            transpose_item(I.w_o_a + (size_t)k0 * 1024 + n0, 1024, nullptr, 1.f, (bf16*)(ws + WS_WOA) + (size_t)n0 * 1024 + k0, 1024, scr, lane); continue; }
        r -= I_WO;
        if (r < 2 * I_GU) { const int l = r / I_GU; r -= l * I_GU; const int kb = r / 176, nb = r % 176, k0 = kb * 64, n0 = nb * 32;
            const int tile = n0 >> 8, j = n0 & 255, src = j < 128 ? tile * 128 + j : FF + tile * 128 + (j - 128);
            transpose_item(I.w_gu + (size_t)l * 1024 * NGU + (size_t)k0 * NGU + src, NGU, I.norm_g + (l * 4 + 2) * 1024 + k0, 1.f, (bf16*)(ws + (l ? WS_WGU1 : WS_WGU0)) + (size_t)n0 * 1024 + k0, 1024, scr, lane); continue; }
        r -= 2 * I_GU;
        if (r < 2 * I_WD) { const int l = r / I_WD; r -= l * I_WD; const int kb = r / 32, nb = r % 32, k0 = kb * 64, n0 = nb * 32;
            transpose_item(I.w_down + (size_t)l * FF * 1024 + (size_t)k0 * 1024 + n0, 1024, nullptr, 1.f, (bf16*)(ws + (l ? WS_WD1 : WS_WD0)) + (size_t)n0 * FF + k0, FF, scr, lane); continue; }
        r -= 2 * I_WD;
        if (r < I_KVQ) { const int kb = r / 144, nb = r % 144, k0 = kb * 64, n0 = nb * 32;
            if (n0 < NKV) transpose_item(I.w_kv + (size_t)k0 * NKV + n0, NKV, I.g_kv + k0, 1.f, (bf16*)(ws + WS_WKVQ) + (size_t)n0 * 1024 + k0, 1024, scr, lane);
            else transpose_item(I.w_q + (size_t)k0 * NQ + (n0 - NKV), NQ, I.norm_g + 4 * 1024 + k0, 0.125f * 1.4426950408889634f, (bf16*)(ws + WS_WKVQ) + (size_t)n0 * 1024 + k0, 1024, scr, lane);
            continue; }
        r -= I_KVQ;
        { const int kb = r / 32, nb = r % 32, k0 = kb * 64, n0 = nb * 32;
            transpose_item(I.w_o_b + (size_t)k0 * 1024 + n0, 1024, nullptr, 1.f, (bf16*)(ws + WS_WOB) + (size_t)n0 * 1024 + k0, 1024, scr, lane); }
    }
    bf16* XB0 = (bf16*)(ws + WS_XB0); float* Abuf = (float*)(ws + WS_ABUF);
    for (int row = gw; row < MT; row += NGW) {
        const float* xr = row < NP ? I.xp + (size_t)row * D : I.xs + (size_t)(row - NP) * D;
        f32x4 v[4]; float ss = 0.f;
#pragma unroll
        for (int j = 0; j < 4; ++j) { v[j] = *(const f32x4*)(xr + 4 * lane + 256 * j); ss += (v[j][0] * v[j][0] + v[j][1] * v[j][1]) + (v[j][2] * v[j][2] + v[j][3] * v[j][3]); }
        const float rstd = rsqrtf(wave_sum(ss) * (1.f / D) + EPS);
        float a[16];
#pragma unroll
        for (int r = 0; r < 16; ++r) a[r] = 0.f;
#pragma unroll
        for (int j = 0; j < 4; ++j) { u32x2 o; o.x = pk2(v[j][0] * rstd, v[j][1] * rstd); o.y = pk2(v[j][2] * rstd, v[j][3] * rstd);
            *(u32x2*)(XB0 + (size_t)row * D + 4 * lane + 256 * j) = o; }
#pragma unroll 1
        for (int j = 0; j < 4; ++j) { const f32x4 xv = *(const f32x4*)(xr + 4 * lane + 256 * j);
#pragma unroll
            for (int i = 0; i < 4; ++i) { const LAS f32x4* w4 = (const LAS f32x4*)(wa + (4 * lane + 256 * j + i) * 16);
#pragma unroll
                for (int q = 0; q < 4; ++q) { const f32x4 w = w4[q]; a[4 * q + 0] += xv[i] * w[0]; a[4 * q + 1] += xv[i] * w[1]; a[4 * q + 2] += xv[i] * w[2]; a[4 * q + 3] += xv[i] * w[3]; } } }
        float mine = 0.f;
#pragma unroll
        for (int r = 0; r < 16; ++r) { const float s = wave_sum(a[r]) * rstd; if (lane == r) mine = s; }
        if (lane < 16) Abuf[(size_t)row * 16 + lane] = mine;
    }
    {
        const size_t gt = (size_t)vcu * 512 + tid, GT = (size_t)G * 512;
#pragma unroll
        for (int g = 0; g < 3; ++g) {
            const int Wg = g == 0 ? 128 : (g == 1 ? 512 : 2048); const float* src = g == 0 ? I.c1 : (g == 1 ? I.c2 : I.c3);
            float* dst = out + (g == 0 ? OFF_W1S : (g == 1 ? OFF_W2S : OFF_W3S));
            const size_t per_b = (size_t)(Wg - 8) * 128;
            const size_t total = per_b * SB;
            for (size_t i = gt; i < total; i += GT) { const size_t b = i / per_b, o = i - b * per_b;
                ((f32x4*)dst)[b * (size_t)Wg * 128 + o] = ((const f32x4*)src)[b * (size_t)Wg * 128 + 8 * 128 + o]; }
        }
    }
    { float* bt = (float*)(ws + WS_BIAS);
      for (int i = vcu * 512 + tid; i < 3 * 16 * NKEYS; i += G * 512) { const int g = i / (16 * NKEYS), hd = (i / NKEYS) % 16, j = i % NKEYS; const int dil = g == 0 ? 1 : (g == 1 ? 4 : 16);
          bt[i] = I.rel_bias[t5_bucket(dil * j) * 48 + g * 16 + hd] * 1.4426950408889634f; } }
}

__device__ __forceinline__ void rownorm_phase(const float* Y, const float* hp_prompt, const float* hp_sample, const float* gain, float* H, bf16* XB, int vcu, int G, int tid) {
    const int lane = tid & 63, wave = tid >> 6; const int gw = vcu * NWAVES + wave, NGW = G * NWAVES;
    f32x4 gv[4];
#pragma unroll
    for (int j = 0; j < 4; ++j) gv[j] = *(const f32x4*)(gain + 4 * lane + 256 * j);
    for (int row = gw; row < MT; row += NGW) {
        const float* yr = Y + (size_t)row * D; const float* hr = row < NP ? hp_prompt + (size_t)row * D : hp_sample + (size_t)(row - NP) * D;
        f32x4 y[4], h[4]; float ss = 0.f;
#pragma unroll
        for (int j = 0; j < 4; ++j) { y[j] = *(const f32x4*)(yr + 4 * lane + 256 * j); h[j] = *(const f32x4*)(hr + 4 * lane + 256 * j); ss += (y[j][0] * y[j][0] + y[j][1] * y[j][1]) + (y[j][2] * y[j][2] + y[j][3] * y[j][3]); }
        const float rstd = rsqrtf(wave_sum(ss) * (1.f / D) + EPS); float s2 = 0.f;
#pragma unroll
        for (int j = 0; j < 4; ++j) { h[j] = h[j] + y[j] * rstd * gv[j]; *(f32x4*)(H + (size_t)row * D + 4 * lane + 256 * j) = h[j]; s2 += (h[j][0] * h[j][0] + h[j][1] * h[j][1]) + (h[j][2] * h[j][2] + h[j][3] * h[j][3]); }
        if (XB) { const float r2 = rsqrtf(wave_sum(s2) * (1.f / D) + EPS);
#pragma unroll
            for (int j = 0; j < 4; ++j) { u32x2 o; o.x = pk2(h[j][0] * r2, h[j][1] * r2); o.y = pk2(h[j][2] * r2, h[j][3] * r2); *(u32x2*)(XB + (size_t)row * D + 4 * lane + 256 * j) = o; } }
    }
}

__device__ __forceinline__ void gla_simple_phase(LAS unsigned char* lds, const bf16* P, const float* Abuf, const In& I, float* out, bf16* XB, int vcu, int G, int tid) {
    LAS float* sq = (LAS float*)lds;
    LAS float* sk = sq + 2048;
    LAS float* sg = sk + 2048;
    LAS float* sv = sg + 2048;
    LAS float* sa = sv + 4096;
    LAS float* so = sa + 256;
    LAS float* sw2 = so + 8192;
    const int lane = tid & 63, wave = tid >> 6, e = tid & 255, dh = tid >> 8;
    for (int u = vcu; u < 192; u += G) {
        int b, h, T, row0; const float* S0; float* Sout;
        if (u < 64) { b = u >> 2; h = u & 3; T = PT; row0 = b * PT; S0 = nullptr; Sout = out + OFF_GLAP + (size_t)(b * 4 + h) * 32768; }
        else { const int su = u - 64; b = su >> 2; h = su & 3; T = ST; row0 = NP + b * ST; S0 = I.state + (size_t)(b * 4 + h) * 32768; Sout = out + OFF_GLAS + (size_t)(b * 4 + h) * 32768; }
        __syncthreads();
        for (int i = tid; i < 2048; i += 512) sw2[i] = I.w_a2[(i >> 7) * 512 + h * 128 + (i & 127)];
        if (tid < 128) sw2[2048 + tid] = I.b_a[h * 128 + tid];
        float S[64];
#pragma unroll
        for (int i = 0; i < 64; ++i) S[i] = S0 ? S0[(size_t)(64 * dh + i) * 256 + e] : 0.f;
        for (int t0 = 0; t0 < T; t0 += 16) {
            const int nb = (T - t0) < 16 ? (T - t0) : 16;
            __syncthreads();
            if (tid < 256) { const int tt = tid >> 4; sa[tid] = tt < nb ? Abuf[(size_t)(row0 + t0 + tt) * 16 + (tid & 15)] : 0.f; }
            __syncthreads();
            for (int idx = tid; idx < 2048; idx += 512) { const int tt = idx >> 7, d = idx & 127;
                if (tt < nb) { float x = sw2[2048 + d];
#pragma unroll
                    for (int r = 0; r < 16; ++r) x += sa[tt * 16 + r] * sw2[r * 128 + d];
                    const float ls = fminf(x, 0.f) - log1pf(expf(-fabsf(x)));
                    sg[idx] = expf(ls * (1.f / 16.f));
                    const bf16* pr = P + (size_t)(row0 + t0 + tt) * NWIN;
                    sq[idx] = bf2f(pr[h * 128 + d]); sk[idx] = bf2f(pr[512 + h * 128 + d]); } }
            for (int idx = tid; idx < 4096; idx += 512) { const int tt = idx >> 8, ee = idx & 255; if (tt < nb) sv[idx] = bf2f(P[(size_t)(row0 + t0 + tt) * NWIN + 1024 + h * 256 + ee]); }
            __syncthreads();
            for (int tt = 0; tt < nb; ++tt) {
                const float ve = sv[tt * 256 + e]; float acc = 0.f;
                const LAS f32x4* g4 = (const LAS f32x4*)(sg + tt * 128 + 64 * dh); const LAS f32x4* k4 = (const LAS f32x4*)(sk + tt * 128 + 64 * dh); const LAS f32x4* q4 = (const LAS f32x4*)(sq + tt * 128 + 64 * dh);
#pragma unroll
                for (int i4 = 0; i4 < 16; ++i4) { const f32x4 gg = g4[i4], kk = k4[i4], qq = q4[i4];
#pragma unroll
                    for (int c = 0; c < 4; ++c) { S[4 * i4 + c] = S[4 * i4 + c] * gg[c] + kk[c] * ve; acc += qq[c] * S[4 * i4 + c]; } }
                so[(tt * 2 + dh) * 256 + e] = acc;
            }
            __syncthreads();
            for (int tt = wave; tt < nb; tt += 8) {
                const int e0 = lane * 4; const f32x4 o0 = *(const LAS f32x4*)(so + (tt * 2 + 0) * 256 + e0), o1 = *(const LAS f32x4*)(so + (tt * 2 + 1) * 256 + e0);
                const f32x4 o = o0 + o1; const float ss = wave_sum((o[0] * o[0] + o[1] * o[1]) + (o[2] * o[2] + o[3] * o[3])); const float rstd = rsqrtf(ss * (1.f / 256.f) + EPS);
                const size_t row = (size_t)(row0 + t0 + tt); const u32x2 rr = *(const u32x2*)(P + row * NWIN + 2048 + h * 256 + e0); const f32x4 gn = *(const f32x4*)(I.gon + e0);
                const float r0 = bflo(rr.x), r1 = bfhi(rr.x), r2 = bflo(rr.y), r3 = bfhi(rr.y);
                u32x2 w; w.x = pk2(o[0] * rstd * gn[0] * silu_f(r0), o[1] * rstd * gn[1] * silu_f(r1)); w.y = pk2(o[2] * rstd * gn[2] * silu_f(r2), o[3] * rstd * gn[3] * silu_f(r3));
                *(u32x2*)(XB + row * D + h * 256 + e0) = w;
            }
        }
#pragma unroll
        for (int i = 0; i < 64; ++i) Sout[(size_t)(64 * dh + i) * 256 + e] = S[i];
    }
}

typedef short bf16x8 __attribute__((ext_vector_type(8)));
typedef short s16x4 __attribute__((ext_vector_type(4)));
typedef float f32x16 __attribute__((ext_vector_type(16)));
__device__ __forceinline__ s16x4 vtr(const LAS unsigned char* p) { return __builtin_bit_cast(s16x4, __builtin_amdgcn_ds_read_tr16_b64_v4i16((LAS s16x4*)p)); }

typedef float f32x4v __attribute__((ext_vector_type(4)));
__device__ __forceinline__ int qk_off(int t, int d) { return t * 272 + d * 2; }
__device__ __forceinline__ int r128_off(int r, int c) { return r * 144 + c * 2; }
__device__ __forceinline__ void gla_mfma_phase(LAS unsigned char* lds, const bf16* P, const float* Abuf, const In& I, float* out, bf16* XB, int vcu, int G, int tid) {
    const int lane = tid & 63, w = tid >> 6, r32 = lane & 31, h2 = lane >> 5, d = tid & 127, tq = tid >> 7;
    LAS unsigned char* QT = lds; LAS unsigned char* KT = lds + 17408; LAS unsigned char* KDT = lds + 34816; LAS unsigned char* AT = lds + 53248;
    LAS float* OST = (LAS float*)lds;
    LAS unsigned char* Vt = lds + 65536;
    LAS float* SA = (LAS float*)(lds + 98304);
    LAS float* TOT = (LAS float*)(lds + 102400);
    LAS float* DL = (LAS float*)(lds + 104448);
    LAS float* GL = (LAS float*)(lds + 104960);
    LAS float* SW2 = (LAS float*)(lds + 137728);
    const int vlane = ((lane >> 4) & 1) * 32 + (lane & 3) * 8 + ((lane & 15) >> 2) * 64;
    for (int u = vcu; u < 192; u += G) {
        int b, hh, T, row0; const float* S0; float* Sout;
        if (u < 64) { b = u >> 2; hh = u & 3; T = PT; row0 = b * PT; S0 = nullptr; Sout = out + OFF_GLAP + (size_t)(b * 4 + hh) * 32768; }
        else { const int su = u - 64; b = su >> 2; hh = su & 3; T = ST; row0 = NP + b * ST; S0 = I.state + (size_t)(b * 4 + hh) * 32768; Sout = out + OFF_GLAS + (size_t)(b * 4 + hh) * 32768; }
        __syncthreads();
        for (int i = tid; i < 2048; i += 512) SW2[i] = I.w_a2[(i >> 7) * 512 + hh * 128 + (i & 127)];
        if (tid < 128) SW2[2048 + tid] = I.b_a[hh * 128 + tid];
        f32x16 S[4];
#pragma unroll
        for (int db = 0; db < 4; ++db)
#pragma unroll
            for (int rg = 0; rg < 16; ++rg) S[db][rg] = S0 ? S0[(size_t)(32 * db + (rg & 3) + 8 * (rg >> 2) + 4 * h2) * 256 + 32 * w + r32] : 0.f;
#pragma unroll 1
        for (int t0 = 0; t0 < T; t0 += 64) {
            const int nv = (T - t0) < 64 ? (T - t0) : 64; const size_t rbase = (size_t)(row0 + t0);
            __syncthreads();
            for (int i = tid; i < 1024; i += 512) SA[i] = (i >> 4) < nv ? Abuf[(rbase + (i >> 4)) * 16 + (i & 15)] : 0.f;
            for (int q = tid; q < 2048; q += 512) { const int n = q >> 5, ch = q & 31; u32x4 v = {0u, 0u, 0u, 0u};
                if (n < nv) v = *(const u32x4*)(P + (rbase + n) * NWIN + 1024 + hh * 256 + ch * 8);
                *(LAS u32x4*)(Vt + ((n >> 3) * 8 + (ch >> 2)) * 512 + (n & 7) * 64 + (ch & 3) * 16) = v; }
            __syncthreads();
            float run = 0.f;
#pragma unroll 2
            for (int i = 0; i < 16; ++i) { const int tt = 16 * tq + i; float x = SW2[2048 + d];
                const LAS f32x4v* a4 = (const LAS f32x4v*)(SA + tt * 16);
#pragma unroll
                for (int q = 0; q < 4; ++q) { const f32x4v av = a4[q]; x += av[0] * SW2[(4 * q) * 128 + d] + av[1] * SW2[(4 * q + 1) * 128 + d] + av[2] * SW2[(4 * q + 2) * 128 + d] + av[3] * SW2[(4 * q + 3) * 128 + d]; }
                const float ls = fminf(x, 0.f) - __logf(1.f + __expf(-fabsf(x)));
                run += (tt < nv) ? ls * (1.f / 16.f) : 0.f; GL[tt * 128 + d] = run; }
            TOT[tq * 128 + d] = run;
            __syncthreads();
            float pre = 0.f, blast = 0.f;
#pragma unroll
            for (int q = 0; q < 4; ++q) { const float tv = TOT[q * 128 + d]; blast += tv; if (q < tq) pre += tv; }
            const float dl = __expf(blast);
            if (tq == 0) DL[d] = dl;
            unsigned kdp[8];
#pragma unroll
            for (int i = 0; i < 16; i += 2) {
                const int tt = 16 * tq + i; const bool ok0 = tt < nv, ok1 = tt + 1 < nv;
                const bf16* pr0 = P + (rbase + (ok0 ? tt : 0)) * NWIN + hh * 128 + d; const bf16* pr1 = P + (rbase + (ok1 ? tt + 1 : 0)) * NWIN + hh * 128 + d;
                const float q0 = ok0 ? bf2f(pr0[0]) : 0.f, k0 = ok0 ? bf2f(pr0[512]) : 0.f, q1 = ok1 ? bf2f(pr1[0]) : 0.f, k1 = ok1 ? bf2f(pr1[512]) : 0.f;
                const float b0 = pre + GL[tt * 128 + d], b1 = pre + GL[(tt + 1) * 128 + d];
                const float qt0 = q0 * __expf(b0), qt1 = q1 * __expf(b1), kt0 = k0 * __expf(-b0), kt1 = k1 * __expf(-b1);
                *(LAS unsigned short*)(QT + qk_off(tt, d)) = (unsigned short)(pk2(qt0, 0.f) & 0xffffu); *(LAS unsigned short*)(QT + qk_off(tt + 1, d)) = (unsigned short)(pk2(qt1, 0.f) & 0xffffu);
                *(LAS unsigned short*)(KT + qk_off(tt, d)) = (unsigned short)(pk2(kt0, 0.f) & 0xffffu); *(LAS unsigned short*)(KT + qk_off(tt + 1, d)) = (unsigned short)(pk2(kt1, 0.f) & 0xffffu);
                kdp[i >> 1] = pk2(kt0 * dl, kt1 * dl); }
            { u32x4 k0 = {kdp[0], kdp[1], kdp[2], kdp[3]}, k1 = {kdp[4], kdp[5], kdp[6], kdp[7]};
              *(LAS u32x4*)(KDT + r128_off(d, 16 * tq)) = k0; *(LAS u32x4*)(KDT + r128_off(d, 16 * tq + 8)) = k1; }
            __syncthreads();
#pragma unroll
            for (int tt2 = 0; tt2 < 2; ++tt2) { const int Tl = 2 * w + tt2, ti = Tl >> 2, tj = Tl & 3; const int lr = lane & 15, kq = lane >> 4;
                f32x4v acc = {0.f, 0.f, 0.f, 0.f};
                if (ti >= tj) {
#pragma unroll
                    for (int ks = 0; ks < 4; ++ks) { const bf16x8 a = *(const LAS bf16x8*)(QT + qk_off(16 * ti + lr, 32 * ks + 8 * kq)); const bf16x8 bb = *(const LAS bf16x8*)(KT + qk_off(16 * tj + lr, 32 * ks + 8 * kq));
                        acc = __builtin_amdgcn_mfma_f32_16x16x32_bf16(a, bb, acc, 0, 0, 0); } }
#pragma unroll
                for (int rg = 0; rg < 4; ++rg) { const int i = 16 * ti + 4 * kq + rg, j = 16 * tj + lr; const float v = (j <= i) ? acc[rg] : 0.f;
                    *(LAS unsigned short*)(AT + r128_off(i, j)) = (unsigned short)(pk2(v, 0.f) & 0xffffu); } }
            __syncthreads();
            f32x16 o0 = {0.f, 0.f, 0.f, 0.f, 0.f, 0.f, 0.f, 0.f, 0.f, 0.f, 0.f, 0.f, 0.f, 0.f, 0.f, 0.f}, o1 = o0;
#pragma unroll
            for (int db = 0; db < 4; ++db)
#pragma unroll
                for (int s = 0; s < 2; ++s) {
                    u32x4 sw; sw.x = pk2(S[db][8 * s + 0], S[db][8 * s + 1]); sw.y = pk2(S[db][8 * s + 2], S[db][8 * s + 3]); sw.z = pk2(S[db][8 * s + 4], S[db][8 * s + 5]); sw.w = pk2(S[db][8 * s + 6], S[db][8 * s + 7]);
                    const bf16x8 sb = __builtin_bit_cast(bf16x8, sw);
                    const int dd = 32 * db + 16 * s + 4 * h2;
                    const u32x2 a00 = *(const LAS u32x2*)(QT + qk_off(r32, dd)), a01 = *(const LAS u32x2*)(QT + qk_off(r32, dd + 8));
                    const u32x2 a10 = *(const LAS u32x2*)(QT + qk_off(32 + r32, dd)), a11 = *(const LAS u32x2*)(QT + qk_off(32 + r32, dd + 8));
                    const u32x4 A0 = {a00.x, a00.y, a01.x, a01.y}, A1 = {a10.x, a10.y, a11.x, a11.y};
                    o0 = __builtin_amdgcn_mfma_f32_32x32x16_bf16(__builtin_bit_cast(bf16x8, A0), sb, o0, 0, 0, 0);
                    o1 = __builtin_amdgcn_mfma_f32_32x32x16_bf16(__builtin_bit_cast(bf16x8, A1), sb, o1, 0, 0, 0);
                    __builtin_amdgcn_sched_barrier(0);
                }
            bf16x8 vf[4];
#pragma unroll
            for (int ks = 0; ks < 4; ++ks) { const LAS unsigned char* vb = Vt + ((2 * ks + h2) * 8 + w) * 512 + vlane; const s16x4 x0 = vtr(vb), x1 = vtr(vb + 256);
                vf[ks] = (bf16x8){x0[0], x0[1], x0[2], x0[3], x1[0], x1[1], x1[2], x1[3]}; }
#pragma unroll
            for (int ks = 0; ks < 4; ++ks) {
                if (ks < 2) { const bf16x8 a = *(const LAS bf16x8*)(AT + r128_off(r32, 16 * ks + 8 * h2)); o0 = __builtin_amdgcn_mfma_f32_32x32x16_bf16(a, vf[ks], o0, 0, 0, 0); }
                { const bf16x8 a = *(const LAS bf16x8*)(AT + r128_off(32 + r32, 16 * ks + 8 * h2)); o1 = __builtin_amdgcn_mfma_f32_32x32x16_bf16(a, vf[ks], o1, 0, 0, 0); } }
            __builtin_amdgcn_sched_barrier(0);
#pragma unroll
            for (int db = 0; db < 4; ++db) {
                __builtin_amdgcn_sched_barrier(0);
#pragma unroll
                for (int rq = 0; rq < 4; ++rq) { const f32x4v dv = *(const LAS f32x4v*)(DL + 32 * db + 8 * rq + 4 * h2);
                    S[db][4 * rq + 0] *= dv[0]; S[db][4 * rq + 1] *= dv[1]; S[db][4 * rq + 2] *= dv[2]; S[db][4 * rq + 3] *= dv[3]; }
#pragma unroll
                for (int ks = 0; ks < 4; ++ks) { const bf16x8 a = *(const LAS bf16x8*)(KDT + r128_off(32 * db + r32, 16 * ks + 8 * h2)); S[db] = __builtin_amdgcn_mfma_f32_32x32x16_bf16(a, vf[ks], S[db], 0, 0, 0); } }
            __syncthreads();
#pragma unroll
            for (int rg = 0; rg < 16; ++rg) { const int i = (rg & 3) + 8 * (rg >> 2) + 4 * h2; OST[i * 256 + 32 * w + r32] = o0[rg]; OST[(32 + i) * 256 + 32 * w + r32] = o1[rg]; }
            __syncthreads();
#pragma unroll 1
            for (int ii = 0; ii < 8; ++ii) { const int i = 8 * w + ii; if (i >= nv) break;
                const f32x4v o = *(const LAS f32x4v*)(OST + i * 256 + 4 * lane); const float ss = wave_sum((o[0] * o[0] + o[1] * o[1]) + (o[2] * o[2] + o[3] * o[3])); const float rstd = rsqrtf(ss * (1.f / 256.f) + EPS);
                const size_t row = rbase + i; const u32x2 rr = *(const u32x2*)(P + row * NWIN + 2048 + hh * 256 + 4 * lane); const f32x4v gn = *(const f32x4v*)(I.gon + 4 * lane);
                u32x2 ww; ww.x = pk2(o[0] * rstd * gn[0] * silu_f(bflo(rr.x)), o[1] * rstd * gn[1] * silu_f(bfhi(rr.x))); ww.y = pk2(o[2] * rstd * gn[2] * silu_f(bflo(rr.y)), o[3] * rstd * gn[3] * silu_f(bfhi(rr.y)));
                *(u32x2*)(XB + row * D + hh * 256 + 4 * lane) = ww; }
        }
#pragma unroll
        for (int db = 0; db < 4; ++db)
#pragma unroll
            for (int rg = 0; rg < 16; ++rg) Sout[(size_t)(32 * db + (rg & 3) + 8 * (rg >> 2) + 4 * h2) * 256 + 32 * w + r32] = S[db][rg];
    }
    __syncthreads();
}

__device__ __forceinline__ void attn_simple_phase(LAS unsigned char* lds, const bf16* Qb, const bf16* KV, const In& I, const float* biasT, bf16* XB, int vcu, int G, int tid, int row_lo, int row_hi) {
    const int lane = tid & 63, wave = tid >> 6; const int gw = vcu * NWAVES + wave, NGW = G * NWAVES;
    LAS float* sqw = (LAS float*)(lds + wave * 10240);
    LAS float* sp = sqw + 256;
    for (int task = gw + row_lo * 4; task < row_hi * 4; task += NGW) {
        const int row = task >> 2, kvh = task & 3; const bool prompt = row < NP;
        const int b = prompt ? (row >> 11) : ((row - NP) >> 3), t = prompt ? (row & 2047) : ((row - NP) & 7);
#pragma unroll
        for (int g = 0; g < 3; ++g) {
            const int dil = g == 0 ? 1 : (g == 1 ? 4 : 16), Wg = g == 0 ? 128 : (g == 1 ? 512 : 2048); const float* cache = g == 0 ? I.c1 : (g == 1 ? I.c2 : I.c3);
            asm volatile("s_waitcnt lgkmcnt(0)" ::: "memory");
#pragma unroll
            for (int i = 0; i < 4; ++i) sqw[lane + 64 * i] = bf2f(Qb[(size_t)row * NQ + g * 1024 + kvh * 256 + lane + 64 * i]);
            asm volatile("s_waitcnt lgkmcnt(0)" ::: "memory");
#pragma unroll 1
            for (int rd = 0; rd < 3; ++rd) {
                const int j = rd * 64 + lane; bool valid = j < NKEYS; const bf16* kb = nullptr; const float* kf = nullptr;
                if (prompt) { const int idx = t - dil * j; valid = valid && idx >= 0; kb = KV + (size_t)(b * PT + (idx < 0 ? 0 : idx)) * NKV + g * 512 + kvh * 64; }
                else { const int idf = Wg + t - dil * j; if (idf >= Wg) kb = KV + (size_t)(NP + b * ST + (idf - Wg)) * NKV + g * 512 + kvh * 64; else kf = cache + ((size_t)(b * Wg + (idf < 0 ? 0 : idf)) * 2) * 256 + kvh * 64; }
                float d0 = 0.f, d1 = 0.f, d2 = 0.f, d3 = 0.f;
                if (valid) {
#pragma unroll 1
                    for (int c = 0; c < 8; ++c) { float kv[8];
                        if (kb) { const u32x4 w = *(const u32x4*)(kb + c * 8); kv[0] = bflo(w.x); kv[1] = bfhi(w.x); kv[2] = bflo(w.y); kv[3] = bfhi(w.y); kv[4] = bflo(w.z); kv[5] = bfhi(w.z); kv[6] = bflo(w.w); kv[7] = bfhi(w.w); }
                        else { const f32x4 w0 = *(const f32x4*)(kf + c * 8), w1 = *(const f32x4*)(kf + c * 8 + 4); kv[0] = w0[0]; kv[1] = w0[1]; kv[2] = w0[2]; kv[3] = w0[3]; kv[4] = w1[0]; kv[5] = w1[1]; kv[6] = w1[2]; kv[7] = w1[3]; }
#pragma unroll
                        for (int i = 0; i < 8; ++i) { d0 += sqw[c * 8 + i] * kv[i]; d1 += sqw[64 + c * 8 + i] * kv[i]; d2 += sqw[128 + c * 8 + i] * kv[i]; d3 += sqw[192 + c * 8 + i] * kv[i]; } }
                }
                const float* bt = biasT + (size_t)(g * 16 + kvh * 4) * NKEYS + (j < NKEYS ? j : 0);
                sp[(0 * 3 + g) * 192 + j] = valid ? d0 + bt[0] : -INFINITY; sp[(1 * 3 + g) * 192 + j] = valid ? d1 + bt[NKEYS] : -INFINITY;
                sp[(2 * 3 + g) * 192 + j] = valid ? d2 + bt[2 * NKEYS] : -INFINITY; sp[(3 * 3 + g) * 192 + j] = valid ? d3 + bt[3 * NKEYS] : -INFINITY;
            }
        }
        asm volatile("s_waitcnt lgkmcnt(0)" ::: "memory");
        float linv[4];
#pragma unroll
        for (int qq = 0; qq < 4; ++qq) {
            float m = -INFINITY;
#pragma unroll 1
            for (int i = 0; i < 9; ++i) m = fmaxf(m, sp[qq * 576 + i * 64 + lane]);
            m = wave_max(m); float l = 0.f;
#pragma unroll 1
            for (int i = 0; i < 9; ++i) { const float p = exp2f(sp[qq * 576 + i * 64 + lane] - m); l += p; sp[qq * 576 + i * 64 + lane] = p; }
            linv[qq] = 1.f / wave_sum(l);
        }
        asm volatile("s_waitcnt lgkmcnt(0)" ::: "memory");
        float o0 = 0.f, o1 = 0.f, o2 = 0.f, o3 = 0.f;
#pragma unroll
        for (int g = 0; g < 3; ++g) {
            const int dil = g == 0 ? 1 : (g == 1 ? 4 : 16), Wg = g == 0 ? 128 : (g == 1 ? 512 : 2048); const float* cache = g == 0 ? I.c1 : (g == 1 ? I.c2 : I.c3);
#pragma unroll 2
            for (int j = 0; j < NKEYS; ++j) {
                float v;
                if (prompt) { const int idx = t - dil * j; if (idx < 0) break; v = bf2f(KV[(size_t)(b * PT + idx) * NKV + g * 512 + 256 + kvh * 64 + lane]); }
                else { const int idf = Wg + t - dil * j; if (idf >= Wg) v = bf2f(KV[(size_t)(NP + b * ST + (idf - Wg)) * NKV + g * 512 + 256 + kvh * 64 + lane]); else v = cache[((size_t)(b * Wg + idf) * 2 + 1) * 256 + kvh * 64 + lane]; }
                o0 += sp[(0 * 3 + g) * 192 + j] * v; o1 += sp[(1 * 3 + g) * 192 + j] * v; o2 += sp[(2 * 3 + g) * 192 + j] * v; o3 += sp[(3 * 3 + g) * 192 + j] * v;
            }
        }
        bf16* orow = XB + (size_t)row * D + kvh * 256 + lane;
        orow[0] = (bf16)(pk2(o0 * linv[0], 0.f) & 0xffffu); orow[64] = (bf16)(pk2(o1 * linv[1], 0.f) & 0xffffu); orow[128] = (bf16)(pk2(o2 * linv[2], 0.f) & 0xffffu); orow[192] = (bf16)(pk2(o3 * linv[3], 0.f) & 0xffffu);
    }
}


__device__ __forceinline__ void attn_mfma_phase(LAS unsigned char* lds, const bf16* Qb, const bf16* KV, const float* biasT, bf16* SCR, float* LST, bf16* XB, int vcu, int G, int tid) {
    const int lane = tid & 63, wave = tid >> 6, r32 = lane & 31, h = lane >> 5, hq = wave & 3, p = wave >> 2, ltid = tid & 255;
    LAS unsigned char* Kt = lds + p * 20480;
    LAS unsigned char* Vt = lds + 40960 + p * 20480;
    LAS float* sbias = (LAS float*)(lds + 81920);
    const int vlane = ((lane >> 4) & 1) * 32 + (lane & 3) * 8 + (4 * h + ((lane & 15) >> 2)) * 64;
    for (int u = vcu; u < 256; u += G) {
        const int b = u >> 4, kvh = (u >> 2) & 3, blk = u & 3, T0 = blk * 512, hd = kvh * 4 + hq;
#pragma unroll 1
        for (int gi = 0; gi < 3; ++gi) {
            const int g = 2 - gi, dsh = 2 * g, dil = 1 << dsh, tsh = 4 - dsh;
            __syncthreads();
            for (int i = tid; i < 768; i += 512) { const int hh = i / 192, j = i % 192 - 32; sbias[i] = (j >= 0 && j <= 128) ? biasT[(size_t)(g * 16 + kvh * 4 + hh) * NKEYS + j] : -INFINITY; }
#pragma unroll 1
            for (int round = 0; round < 8; ++round) {
                const int tau = 2 * round + p, s = tau >> tsh, c = tau & ((1 << tsh) - 1), ifirst = (T0 >> dsh) + 32 * c;
                __syncthreads();
                for (int q = ltid; q < 1280; q += 256) { const int n = q >> 3, ch = q & 7, i = ifirst - 128 + n;
                    u32x4 kx = {0u, 0u, 0u, 0u}, vx = {0u, 0u, 0u, 0u};
                    if (i >= 0) { const bf16* src = KV + (size_t)(b * PT + (i << dsh) + s) * NKV + g * 512 + kvh * 64 + ch * 8; kx = *(const u32x4*)src; vx = *(const u32x4*)(src + 256); }
                    *(LAS u32x4*)(Kt + (ch * 160 + n) * 16) = kx;
                    *(LAS u32x4*)(Vt + ((n >> 3) * 2 + (ch >> 2)) * 512 + (n & 7) * 64 + (ch & 3) * 16) = vx; }
                __syncthreads();
                const int token = T0 + ((32 * c + r32) << dsh) + s; const size_t qrow = (size_t)(b * PT + token);
                bf16x8 qf[4];
#pragma unroll
                for (int ks = 0; ks < 4; ++ks) qf[ks] = *(const bf16x8*)(Qb + qrow * NQ + g * 1024 + hd * 64 + 16 * ks + 8 * h);
                f32x16 S[5]; float m = -INFINITY;
#pragma unroll
                for (int kc = 0; kc < 5; ++kc) {
                    if (ifirst - 128 + 32 * kc >= 0) {
                        f32x16 acc = {0.f, 0.f, 0.f, 0.f, 0.f, 0.f, 0.f, 0.f, 0.f, 0.f, 0.f, 0.f, 0.f, 0.f, 0.f, 0.f};
#pragma unroll
                        for (int ks = 0; ks < 4; ++ks) { const bf16x8 a = *(const LAS bf16x8*)(Kt + ((2 * ks + h) * 160 + 32 * kc + r32) * 16); acc = __builtin_amdgcn_mfma_f32_32x32x16_bf16(a, qf[ks], acc, 0, 0, 0); }
                        const LAS float* bp = sbias + hq * 192 + (160 - 32 * kc + r32 - 4 * h);
#pragma unroll
                        for (int rg = 0; rg < 16; ++rg) { acc[rg] += bp[-((rg & 3) + 8 * (rg >> 2))]; m = fmaxf(m, acc[rg]); }
                        S[kc] = acc;
                    } else {
#pragma unroll
                        for (int rg = 0; rg < 16; ++rg) S[kc][rg] = -INFINITY;
                    }
                }
                m = fmaxf(m, __shfl_xor(m, 32));
                float l = 0.f;
#pragma unroll
                for (int kc = 0; kc < 5; ++kc)
#pragma unroll
                    for (int rg = 0; rg < 16; ++rg) { const float pv = __builtin_amdgcn_exp2f(S[kc][rg] - m); l += pv; S[kc][rg] = pv; }
                l += __shfl_xor(l, 32);
                f32x16 O0 = {0.f, 0.f, 0.f, 0.f, 0.f, 0.f, 0.f, 0.f, 0.f, 0.f, 0.f, 0.f, 0.f, 0.f, 0.f, 0.f}, O1 = O0;
#pragma unroll
                for (int kc = 0; kc < 5; ++kc) {
                    if (ifirst - 128 + 32 * kc >= 0) {
#pragma unroll
                        for (int s2 = 0; s2 < 2; ++s2) {
                            u32x4 pw; pw.x = pk2(S[kc][8 * s2 + 0], S[kc][8 * s2 + 1]); pw.y = pk2(S[kc][8 * s2 + 2], S[kc][8 * s2 + 3]); pw.z = pk2(S[kc][8 * s2 + 4], S[kc][8 * s2 + 5]); pw.w = pk2(S[kc][8 * s2 + 6], S[kc][8 * s2 + 7]);
                            const bf16x8 pb = __builtin_bit_cast(bf16x8, pw);
                            const LAS unsigned char* vb = Vt + ((4 * kc + 2 * s2) * 2) * 512 + vlane;
                            const s16x4 a0 = vtr(vb), a1 = vtr(vb + 1024), c0 = vtr(vb + 512), c1 = vtr(vb + 1536);
                            const bf16x8 va = {a0[0], a0[1], a0[2], a0[3], a1[0], a1[1], a1[2], a1[3]}, vc = {c0[0], c0[1], c0[2], c0[3], c1[0], c1[1], c1[2], c1[3]};
                            O0 = __builtin_amdgcn_mfma_f32_32x32x16_bf16(va, pb, O0, 0, 0, 0);
                            O1 = __builtin_amdgcn_mfma_f32_32x32x16_bf16(vc, pb, O1, 0, 0, 0);
                        }
                    }
                }
                bf16* srow = SCR + qrow * D + hd * 64 + 4 * h; float* lrow = LST + (qrow * 16 + hd) * 2;
                if (gi > 0) {
                    const float mp = lrow[0], lp = lrow[1]; const float mn = fmaxf(m, mp), fa = exp2f(mp - mn), fb = exp2f(m - mn);
                    l = l * fb + lp * fa; m = mn;
#pragma unroll
                    for (int rq = 0; rq < 4; ++rq) { const u32x2 w0 = *(const u32x2*)(srow + 8 * rq), w1 = *(const u32x2*)(srow + 32 + 8 * rq);
                        O0[4 * rq + 0] = O0[4 * rq + 0] * fb + bflo(w0.x) * fa; O0[4 * rq + 1] = O0[4 * rq + 1] * fb + bfhi(w0.x) * fa; O0[4 * rq + 2] = O0[4 * rq + 2] * fb + bflo(w0.y) * fa; O0[4 * rq + 3] = O0[4 * rq + 3] * fb + bfhi(w0.y) * fa;
                        O1[4 * rq + 0] = O1[4 * rq + 0] * fb + bflo(w1.x) * fa; O1[4 * rq + 1] = O1[4 * rq + 1] * fb + bfhi(w1.x) * fa; O1[4 * rq + 2] = O1[4 * rq + 2] * fb + bflo(w1.y) * fa; O1[4 * rq + 3] = O1[4 * rq + 3] * fb + bfhi(w1.y) * fa; }
                }
                if (gi < 2) {
                    if (h == 0) { lrow[0] = m; lrow[1] = l; }
#pragma unroll
                    for (int rq = 0; rq < 4; ++rq) { u32x2 w0, w1; w0.x = pk2(O0[4 * rq], O0[4 * rq + 1]); w0.y = pk2(O0[4 * rq + 2], O0[4 * rq + 3]); w1.x = pk2(O1[4 * rq], O1[4 * rq + 1]); w1.y = pk2(O1[4 * rq + 2], O1[4 * rq + 3]);
                        *(u32x2*)(srow + 8 * rq) = w0; *(u32x2*)(srow + 32 + 8 * rq) = w1; }
                } else {
                    const float li = 1.f / l; bf16* orow = XB + qrow * D + hd * 64 + 4 * h;
#pragma unroll
                    for (int rq = 0; rq < 4; ++rq) { u32x2 w0, w1; w0.x = pk2(O0[4 * rq] * li, O0[4 * rq + 1] * li); w0.y = pk2(O0[4 * rq + 2] * li, O0[4 * rq + 3] * li); w1.x = pk2(O1[4 * rq] * li, O1[4 * rq + 1] * li); w1.y = pk2(O1[4 * rq + 2] * li, O1[4 * rq + 3] * li);
                        *(u32x2*)(orow + 8 * rq) = w0; *(u32x2*)(orow + 32 + 8 * rq) = w1; }
                }
            }
        }
    }
    __syncthreads();
}

struct Args { const float* in[19]; float* out; unsigned char* ws; int ph_lo, ph_hi; };
__global__ void __launch_bounds__(NWAVES * 64, 2) fwd(Args a) {
    extern __shared__ __attribute__((aligned(16))) unsigned char lds_raw[];
    LAS unsigned char* lds = (LAS unsigned char*)lds_raw;
    cg::grid_group grid = cg::this_grid();
    const int tid = threadIdx.x, G = gridDim.x; const int bx = blockIdx.x; const int vcu = (G % 8 == 0) ? (bx % 8) * (G / 8) + bx / 8 : bx;
    In I; I.xp = a.in[0]; I.xs = a.in[1]; I.state = a.in[2]; I.c1 = a.in[3]; I.c2 = a.in[4]; I.c3 = a.in[5]; I.norm_g = a.in[6]; I.w_in = a.in[7]; I.w_a2 = a.in[8]; I.b_a = a.in[9]; I.gon = a.in[10];
    I.w_o_a = a.in[11]; I.g_kv = a.in[12]; I.w_kv = a.in[13]; I.w_q = a.in[14]; I.w_o_b = a.in[15]; I.rel_bias = a.in[16]; I.w_gu = a.in[17]; I.w_down = a.in[18];
    unsigned char* ws = a.ws; float* out = a.out;
    bf16* XB0 = (bf16*)(ws + WS_XB0); bf16* XB1 = (bf16*)(ws + WS_XB1); bf16* BIG = (bf16*)(ws + WS_BIG); float* Y = (float*)(ws + WS_YKV); bf16* KVb = (bf16*)(ws + WS_YKV);
    float* Abuf = (float*)(ws + WS_ABUF); float* biasT = (float*)(ws + WS_BIAS); float* LST = (float*)(ws + WS_LST); float* H = out;
    const int lo = a.ph_lo, hi = a.ph_hi;
#define IN(k) (lo <= (k) && (k) < hi)
#define SEAM(k) do { if (IN(k) && IN((k) + 1)) grid.sync(); } while (0)

    if (IN(0)) { p0_prologue(lds, I, ws, out, vcu, G, tid); } SEAM(0);
    if (IN(1)) { pg8::Gemm g{XB0, (const bf16*)(ws + WS_WIN), MT, NWIN, D}; pg8::StaticOrder S; S.init(MT, NWIN, G, bx); pg8::EpiBf16 E{BIG, NWIN};
                 pg8::gemm_phase<pg8::EpiBf16, pg8::StaticOrder, true, true>(lds, g, S, E); } SEAM(1);
    if (IN(2)) { for (int rep_ = 0; rep_ < GLA_REP; ++rep_) gla_mfma_phase(lds, BIG, Abuf, I, out, XB0, vcu, G, tid); } SEAM(2);
    if (IN(3)) { pg8::Gemm g{XB0, (const bf16*)(ws + WS_WOA), MT, D, D}; pg8::StaticOrder S; S.init(MT, D, G, bx); pg8::EpiF32 E{Y, D};
                 pg8::gemm_phase<pg8::EpiF32, pg8::StaticOrder, true, true>(lds, g, S, E); } SEAM(3);
    if (IN(4)) { rownorm_phase(Y, I.xp, I.xs, I.norm_g + 1 * 1024, H, XB1, vcu, G, tid); } SEAM(4);
    if (IN(5)) { pg8::Gemm g{XB1, (const bf16*)(ws + WS_WGU0), MT, NGU, D}; pg8::StaticOrder S; S.init(MT, NGU, G, bx); pg8::EpiSwiGLU E{BIG, FF};
                 pg8::gemm_phase<pg8::EpiSwiGLU, pg8::StaticOrder, true, true>(lds, g, S, E); } SEAM(5);
    if (IN(6)) { pg8::Gemm g{BIG, (const bf16*)(ws + WS_WD0), MT, D, FF}; pg8::StaticOrder S; S.init(MT, D, G, bx); pg8::EpiF32 E{Y, D};
                 pg8::gemm_phase<pg8::EpiF32, pg8::StaticOrder, true, true>(lds, g, S, E); } SEAM(6);
    if (IN(7)) { rownorm_phase(Y, H, H + (size_t)NP * D, I.norm_g + 3 * 1024, H, XB0, vcu, G, tid); } SEAM(7);
    if (IN(8)) { pg8::Gemm g{XB0, (const bf16*)(ws + WS_WKVQ), MT, NKVQ, D}; pg8::StaticOrder S; S.init(MT, NKVQ, G, bx); pg8::EpiKVQ E{KVb, BIG, out};
                 pg8::gemm_phase<pg8::EpiKVQ, pg8::StaticOrder, true, true>(lds, g, S, E); } SEAM(8);
    if (IN(9)) { for (int rep_ = 0; rep_ < ATT_REP; ++rep_) { attn_mfma_phase(lds, BIG, KVb, biasT, XB0, LST, XB1, vcu, G, tid); attn_simple_phase(lds, BIG, KVb, I, biasT, XB1, vcu, G, tid, NP, MT); } } SEAM(9);
    if (IN(10)) { pg8::Gemm g{XB1, (const bf16*)(ws + WS_WOB), MT, D, D}; pg8::StaticOrder S; S.init(MT, D, G, bx); pg8::EpiF32 E{Y, D};
                  pg8::gemm_phase<pg8::EpiF32, pg8::StaticOrder, true, true>(lds, g, S, E); } SEAM(10);
    if (IN(11)) { rownorm_phase(Y, H, H + (size_t)NP * D, I.norm_g + 5 * 1024, H, XB0, vcu, G, tid); } SEAM(11);
    if (IN(12)) { pg8::Gemm g{XB0, (const bf16*)(ws + WS_WGU1), MT, NGU, D}; pg8::StaticOrder S; S.init(MT, NGU, G, bx); pg8::EpiSwiGLU E{BIG, FF};
                  pg8::gemm_phase<pg8::EpiSwiGLU, pg8::StaticOrder, true, true>(lds, g, S, E); } SEAM(12);
    if (IN(13)) { pg8::Gemm g{BIG, (const bf16*)(ws + WS_WD1), MT, D, FF}; pg8::StaticOrder S; S.init(MT, D, G, bx); pg8::EpiF32 E{Y, D};
                  pg8::gemm_phase<pg8::EpiF32, pg8::StaticOrder, true, true>(lds, g, S, E); } SEAM(13);
    if (IN(14)) { rownorm_phase(Y, H, H + (size_t)NP * D, I.norm_g + 7 * 1024, H, nullptr, vcu, G, tid); }
#undef IN
#undef SEAM
}

#ifndef ONE_LAUNCH
#define ONE_LAUNCH 1
#endif
extern "C" void kernel_launch(void* const* d_in, const int* in_sizes, int n_in, void* d_out, int out_size, void* d_ws, size_t ws_size, hipStream_t stream) {
    static int grid = 0;
    if (grid == 0) {
        if (n_in != 19 || (size_t)out_size != OUT_TOTAL || ws_size < WS_END) { fprintf(stderr, "kernel_launch: unexpected shapes: n_in %d out %d ws %zu (need %zu)\n", n_in, out_size, ws_size, (size_t)WS_END); grid = -1; return; }
        int dev = 0, cus = 0, per_cu = 0;
        if (hipGetDevice(&dev) != hipSuccess || hipDeviceGetAttribute(&cus, hipDeviceAttributeMultiprocessorCount, dev) != hipSuccess) { grid = -1; return; }
        if (hipFuncSetAttribute((const void*)fwd, hipFuncAttributeMaxDynamicSharedMemorySize, LDS_BYTES) != hipSuccess) { fprintf(stderr, "kernel_launch: hipFuncSetAttribute failed\n"); grid = -1; return; }
        if (hipOccupancyMaxActiveBlocksPerMultiprocessor(&per_cu, (const void*)fwd, NWAVES * 64, LDS_BYTES) != hipSuccess || per_cu < 1) { fprintf(stderr, "kernel_launch: occupancy query says %d blocks per CU\n", per_cu); (void)hipGetLastError(); per_cu = 1; }
        grid = cus;
        if (grid > 256) grid = 256;
    }
    if (grid < 0) return;
    Args a{};
    for (int i = 0; i < 19; ++i) a.in[i] = (const float*)d_in[i];
    a.out = (float*)d_out; a.ws = (unsigned char*)d_ws;
#if ONE_LAUNCH
    a.ph_lo = 0; a.ph_hi = NPHASE;
    void* args[] = {&a};
    hipError_t e = hipLaunchCooperativeKernel((const void*)fwd, dim3(grid), dim3(NWAVES * 64), args, LDS_BYTES, stream);
    if (e != hipSuccess) fprintf(stderr, "cooperative launch failed: %s (grid %d)\n", hipGetErrorString(e), grid);
#else
    for (int ph = 0; ph < NPHASE; ++ph) { a.ph_lo = ph; a.ph_hi = ph + 1; hipLaunchKernelGGL(fwd, dim3(grid), dim3(NWAVES * 64), LDS_BYTES, stream, a); }
#endif
}
```

```cpp
#include <hip/hip_runtime.h>
#include <hip/hip_cooperative_groups.h>
#include <cstdio>
#include <cstdint>
namespace cg = cooperative_groups;
#ifndef GEMM_REP
#define GEMM_REP 1
#endif

constexpr int D = 1024, PB = 16, PT = 2048, SB = 32, ST = 8, PAST = 16384;
constexpr int NP = PB * PT;
constexpr int NS = SB * ST;
constexpr int MT = NP + NS;
constexpr int GH = 4, GDK = 128, GDV = 256, RANK = 16;
constexpr int NIN = 3088;
constexpr int NWIN = 3072;
constexpr int FF = 2816, NGU = 2 * FF;
constexpr int NKV = 1536, NQ = 3072, NKVQ = NKV + NQ;
constexpr int NKEYS = 129;
constexpr float EPS = 1e-6f;
constexpr size_t OFF_YP = 0, OFF_YS = 33554432, OFF_GLAP = 33816576, OFF_W1P = 35913728, OFF_W2P = 36962304, OFF_W3P = 41156608,
                 OFF_GLAS = 57933824, OFF_W1S = 62128128, OFF_W2S = 64225280, OFF_W3S = 72613888, OUT_TOTAL = 106168320;
constexpr size_t MiB = 1u << 20;
constexpr size_t WS_CTL = 0;
constexpr size_t WS_WIN = 1 * MiB;
constexpr size_t WS_WOA = WS_WIN + 6 * MiB;
constexpr size_t WS_WGU0 = WS_WOA + 2 * MiB;
constexpr size_t WS_WD0 = WS_WGU0 + 11 * MiB;
constexpr size_t WS_WKVQ = WS_WD0 + 11 * MiB / 2;
constexpr size_t WS_WOB = WS_WKVQ + 9 * MiB;
constexpr size_t WS_WGU1 = WS_WOB + 2 * MiB;
constexpr size_t WS_WD1 = WS_WGU1 + 11 * MiB;
constexpr size_t WS_ABUF = 53 * MiB;
constexpr size_t WS_BIAS = 55 * MiB + 512 * 1024;
constexpr size_t WS_XB0 = 56 * MiB;
constexpr size_t WS_XB1 = 121 * MiB;
constexpr size_t WS_BIG = 186 * MiB;
constexpr size_t WS_YKV = 380 * MiB;
constexpr size_t WS_LST = 480 * MiB;
constexpr size_t WS_END = 509 * MiB;
static_assert(WS_YKV + (size_t)MT * 1536 * 2 <= WS_LST && WS_LST + (size_t)MT * 32 * 4 <= WS_END, "LST");
static_assert(WS_WD1 + 11 * MiB / 2 <= WS_ABUF && WS_ABUF + (size_t)MT * 16 * 4 <= WS_BIAS && WS_XB0 + (size_t)MT * D * 2 <= WS_XB1 &&
              WS_XB1 + (size_t)MT * D * 2 <= WS_BIG && WS_BIG + (size_t)MT * 3072 * 2 <= WS_YKV && WS_YKV + (size_t)MT * D * 4 <= WS_END, "d_ws map");

constexpr int LDS_BYTES = 147456;
constexpr int NWAVES = 8;
constexpr int NPHASE = 15;

#define LAS __attribute__((address_space(3)))
typedef unsigned short bf16;
typedef float f32x4 __attribute__((ext_vector_type(4)));
typedef float f32x2 __attribute__((ext_vector_type(2)));
typedef unsigned u32x4 __attribute__((ext_vector_type(4)));
typedef unsigned u32x2 __attribute__((ext_vector_type(2)));
typedef __bf16 bf16x2_t __attribute__((ext_vector_type(2)));
__device__ __forceinline__ unsigned pk2(float lo, float hi) { f32x2 v = {lo, hi}; bf16x2_t b = __builtin_convertvector(v, bf16x2_t); return __builtin_bit_cast(unsigned, b); }
__device__ __forceinline__ float bf2f(unsigned short h) { return __uint_as_float((unsigned)h << 16); }
__device__ __forceinline__ float bflo(unsigned w) { return __uint_as_float(w << 16); }
__device__ __forceinline__ float bfhi(unsigned w) { return __uint_as_float(w & 0xffff0000u); }
__device__ __forceinline__ float wave_sum(float v) {
#pragma unroll
    for (int o = 1; o < 64; o <<= 1) v += __shfl_xor(v, o);
    return v;
}
__device__ __forceinline__ float wave_max(float v) {
#pragma unroll
    for (int o = 1; o < 64; o <<= 1) v = fmaxf(v, __shfl_xor(v, o));
    return v;
}
__device__ __forceinline__ float silu_f(float x) { return x * __builtin_amdgcn_rcpf(1.f + __expf(-x)); }

namespace pg8 {
#define PG8_LAS __attribute__((address_space(3)))
typedef unsigned short bf16_t;
typedef short bf16x8 __attribute__((ext_vector_type(8)));
typedef float f32x4 __attribute__((ext_vector_type(4)));
typedef unsigned u32x4 __attribute__((ext_vector_type(4)));
constexpr int BM = 256, BK = 64, HALF = 128, HTB = HALF * BK * 2  , STAGE_BYTES = 8 * HTB, NXCD = 8, WGM = 8;

__host__ __device__ __forceinline__ int lds_byte(int r, int c) { const int st = (r >> 4) * 2 + (c >> 5), rr = r & 15, cc = c & 31, ob = rr * 64 + cc * 2; return st * 1024 + (ob ^ (((ob >> 9) & 1) << 5)); }
__host__ __device__ __forceinline__ void stage_rc(int b, int& R, int& C) { const int st = b / 1024, sb = b % 1024, swz = sb ^ (((sb >> 9) & 1) << 5); R = (st >> 1) * 16 + swz / 64; C = (st & 1) * 32 + (swz % 64) / 2; }
__host__ __device__ __forceinline__ int perm32(int rho) { const int n = rho >> 4, i = rho & 15; return 8 * (i >> 2) + 4 * n + (i & 3); }

struct Unit { int pm, pn; };
struct Gemm { const bf16_t* A; const bf16_t* Bt; int M, N, K; };

struct StaticOrder {
    int nM, nN, nwg, G, c;
    __host__ __device__ void init(int M, int N, int G_, int c_) { nM = M / BM; nN = N / BM; nwg = nM * nN; G = G_; c = c_; }
    __host__ __device__ bool next(int i, Unit& u) const {
#if GEMM_REP > 1
        { const int mine = (nwg - c + G - 1) / G; if (i >= mine * GEMM_REP) return false; i %= mine; }
#endif
        const long L = (long)i * G + c; if (L >= nwg) return false;
        int wgid = (int)L; { const int q = nwg / NXCD, r = nwg % NXCD, xcd = wgid % NXCD, off = wgid / NXCD; wgid = (xcd < r ? xcd * (q + 1) : r * (q + 1) + (xcd - r) * q) + off; }
        const int nig = WGM * nN, gid = wgid / nig, fm = gid * WGM, gsz = (nM - fm) < WGM ? (nM - fm) : WGM;
        u.pm = fm + ((wgid % nig) % gsz); u.pn = (wgid % nig) / gsz; return true;
    }
    __device__ __forceinline__ void a_ready(const Unit&) const {}
    __device__ __forceinline__ void done(const Unit&) const {}
};


__device__ __forceinline__ unsigned epk2(float lo, float hi) { return ::pk2(lo, hi); }
struct EpiBf16 {
    static constexpr bool PERM = true, AFTER_DRAIN = false;
    bf16_t* O; int ldc;
    __device__ __forceinline__ void operator()(const f32x4 (&acc)[2][2][4][2], const Unit& u, int wr, int wc, int fr, int fq) const {
        const int row0 = u.pm * BM + wr * 64 + fr, col0 = u.pn * BM + wc * 32 + 8 * fq;
#pragma unroll
        for (int ai = 0; ai < 2; ++ai)
#pragma unroll
            for (int m = 0; m < 4; ++m) { bf16_t* rowp = O + (size_t)(row0 + ai * HALF + m * 16) * ldc + col0;
#pragma unroll
                for (int bj = 0; bj < 2; ++bj) { const f32x4 v0 = acc[ai][bj][m][0], v1 = acc[ai][bj][m][1];
                    u32x4 w; w.x = epk2(v0[0], v0[1]); w.y = epk2(v0[2], v0[3]); w.z = epk2(v1[0], v1[1]); w.w = epk2(v1[2], v1[3]);
                    *(u32x4*)(rowp + bj * HALF) = w; } }
    }
};
struct EpiF32 {
    static constexpr bool PERM = false, AFTER_DRAIN = false;
    float* C; int ldc;
    __device__ __forceinline__ void operator()(const f32x4 (&acc)[2][2][4][2], const Unit& u, int wr, int wc, int fr, int fq) const {
        const int row0 = u.pm * BM + wr * 64 + fr, col0 = u.pn * BM + wc * 32 + 4 * fq;
#pragma unroll
        for (int ai = 0; ai < 2; ++ai)
#pragma unroll
            for (int m = 0; m < 4; ++m) { float* rowp = C + (size_t)(row0 + ai * HALF + m * 16) * ldc + col0;
#pragma unroll
                for (int bj = 0; bj < 2; ++bj)
#pragma unroll
                    for (int n = 0; n < 2; ++n) *(f32x4*)(rowp + bj * HALF + n * 16) = acc[ai][bj][m][n]; }
    }
};
struct EpiSwiGLU {
    static constexpr bool PERM = true, AFTER_DRAIN = false;
    bf16_t* Hd; int ldh;
    __device__ __forceinline__ void operator()(const f32x4 (&acc)[2][2][4][2], const Unit& u, int wr, int wc, int fr, int fq) const {
        const int row0 = u.pm * BM + wr * 64 + fr, col0 = u.pn * HALF + wc * 32 + 8 * fq;
#pragma unroll
        for (int ai = 0; ai < 2; ++ai)
#pragma unroll
            for (int m = 0; m < 4; ++m) { bf16_t* rowp = Hd + (size_t)(row0 + ai * HALF + m * 16) * ldh + col0;
                const f32x4 g0 = acc[ai][0][m][0], g1 = acc[ai][0][m][1], u0 = acc[ai][1][m][0], u1 = acc[ai][1][m][1];
                float h[8];
#pragma unroll
                for (int i = 0; i < 4; ++i) { h[i] = ::silu_f(g0[i]) * u0[i]; h[4 + i] = ::silu_f(g1[i]) * u1[i]; }
                u32x4 w; w.x = epk2(h[0], h[1]); w.y = epk2(h[2], h[3]); w.z = epk2(h[4], h[5]); w.w = epk2(h[6], h[7]);
                *(u32x4*)rowp = w; }
    }
};
struct EpiKVQ {
    static constexpr bool PERM = true, AFTER_DRAIN = false;
    bf16_t* KV; bf16_t* Q; float* out;
    __device__ __forceinline__ void operator()(const f32x4 (&acc)[2][2][4][2], const Unit& u, int wr, int wc, int fr, int fq) const {
        const int row0 = u.pm * BM + wr * 64 + fr; const int tcol = wc * 32 + 8 * fq;
        const bool iskv = u.pn < 6;
        bf16_t* base = iskv ? KV + u.pn * BM + tcol : Q + (u.pn - 6) * BM + tcol; const int ldc = iskv ? ::NKV : ::NQ;
        const int g = u.pn >> 1, s = u.pn & 1; const int Wg = g == 0 ? 128 : (g == 1 ? 512 : 2048);
        float* wp = out + (g == 0 ? ::OFF_W1P : (g == 1 ? ::OFF_W2P : ::OFF_W3P)); float* wsm = out + (g == 0 ? ::OFF_W1S : (g == 1 ? ::OFF_W2S : ::OFF_W3S));
#pragma unroll
        for (int ai = 0; ai < 2; ++ai)
#pragma unroll
            for (int m = 0; m < 4; ++m) { const int row = row0 + ai * HALF + m * 16; bf16_t* rowp = base + (size_t)row * ldc;
#pragma unroll
                for (int bj = 0; bj < 2; ++bj) { const f32x4 v0 = acc[ai][bj][m][0], v1 = acc[ai][bj][m][1];
                    u32x4 w; w.x = epk2(v0[0], v0[1]); w.y = epk2(v0[2], v0[3]); w.z = epk2(v1[0], v1[1]); w.w = epk2(v1[2], v1[3]);
                    *(u32x4*)(rowp + bj * HALF) = w; }
                if (iskv) {
                    float* dst = nullptr;
                    if (row < ::NP) { const int b = row >> 11, t = row & 2047, tp = t - (2048 - Wg); if (tp >= 0) dst = wp + ((size_t)(b * Wg + tp) * 512 + s * 256 + tcol); }
                    else { const int sr = row - ::NP, b = sr >> 3, r = sr & 7; dst = wsm + ((size_t)(b * Wg + (Wg - 8 + r)) * 512 + s * 256 + tcol); }
                    if (dst) {
#pragma unroll
                        for (int bj = 0; bj < 2; ++bj) { *(f32x4*)(dst + bj * HALF) = acc[ai][bj][m][0]; *(f32x4*)(dst + bj * HALF + 4) = acc[ai][bj][m][1]; } }
                } }
    }
};

template <class Epi, class Sched, bool ALIGN_EPI = false, bool SP2 = false>
__device__ __forceinline__ void gemm_phase(PG8_LAS unsigned char* lds, const Gemm g, const Sched& S, const Epi& E) {
    const int tid = threadIdx.x, wid = __builtin_amdgcn_readfirstlane(tid >> 6), lane = tid & 63, wr = wid >> 2, wc = wid & 3, fr = lane & 15, fq = lane >> 4;
    const int K = g.K, nt = K / BK;
    unsigned voffA[2], voffB[2];
#pragma unroll
    for (int i = 0; i < 2; ++i) { int R, C; stage_rc(tid * 16 + i * 8192, R, C); const int Rb = Epi::PERM ? ((R & ~31) + perm32(R & 31)) : R;
        voffA[i] = (unsigned)(R * K + C) * 2u; voffB[i] = (unsigned)(Rb * K + C) * 2u; }
    const size_t kstep = (size_t)(BK * 2);
    const size_t hstep = (size_t)HALF * K * 2;
    const size_t tstep = 2 * hstep;
    const unsigned ldsw = (unsigned)wid * 1024u;
    const int aoff = lds_byte(wr * 64 + fr, fq * 8), boff = lds_byte(wc * 32 + fr, fq * 8);
#define PG8_SA(b, h) (((b) * 2 + (h)) * HTB)
#define PG8_SB(b, h) ((4 + (b) * 2 + (h)) * HTB)
#define PG8_STAGE(bufoff, gbase, voff) do { _Pragma("unroll") for (int _i = 0; _i < 2; ++_i) \
        __builtin_amdgcn_global_load_lds((const unsigned*)((const char*)(gbase) + (voff)[_i]), (PG8_LAS unsigned*)(lds + (bufoff) + ldsw + _i * 8192), 16, 0, 0); } while (0)
#define PG8_LDA(dst, b, h) do { _Pragma("unroll") for (int m = 0; m < 4; ++m) _Pragma("unroll") for (int k = 0; k < 2; ++k) dst[m][k] = *(const PG8_LAS bf16x8*)(lds + PG8_SA(b, h) + aoff + m * 2048 + k * 1024); } while (0)
#define PG8_LDB(dst, b, h) do { _Pragma("unroll") for (int n = 0; n < 2; ++n) _Pragma("unroll") for (int k = 0; k < 2; ++k) dst[n][k] = *(const PG8_LAS bf16x8*)(lds + PG8_SB(b, h) + boff + n * 2048 + k * 1024); } while (0)
#define PG8_MMA(ai, bj, At, Bt) do { __builtin_amdgcn_s_setprio(1); _Pragma("unroll") for (int m = 0; m < 4; ++m) _Pragma("unroll") for (int n = 0; n < 2; ++n) _Pragma("unroll") for (int k = 0; k < 2; ++k) \
        acc[ai][bj][m][n] = __builtin_amdgcn_mfma_f32_16x16x32_bf16(Bt[n][k], At[m][k], acc[ai][bj][m][n], 0, 0, 0); __builtin_amdgcn_s_setprio(0); } while (0)
#define PG8_WAIT_V(n) asm volatile("s_waitcnt vmcnt(" #n ")" ::: "memory")
#define PG8_WAIT_L(n) asm volatile("s_waitcnt lgkmcnt(" #n ")" ::: "memory")
#define PG8_BAR __builtin_amdgcn_s_barrier()
#define PG8_SCHED __builtin_amdgcn_sched_barrier(0)
    Unit cur, nxt; int ui = 0;
    if (!S.next(0, cur)) return;
    f32x4 acc[2][2][4][2];
#pragma unroll
    for (int a = 0; a < 2; ++a)
#pragma unroll
        for (int b = 0; b < 2; ++b)
#pragma unroll
            for (int m = 0; m < 4; ++m)
#pragma unroll
                for (int n = 0; n < 2; ++n) acc[a][b][m][n] = (f32x4){0.f, 0.f, 0.f, 0.f};
    bf16x8 At[4][2], B0[2][2], B1[2][2];
    const char* cA = (const char*)g.A + (size_t)cur.pm * tstep; const char* cB = (const char*)g.Bt + (size_t)cur.pn * tstep;
    S.a_ready(cur);
    if constexpr (SP2) {
        PG8_STAGE(PG8_SB(0, 0), cB, voffB); PG8_STAGE(PG8_SB(0, 1), cB + hstep, voffB); PG8_STAGE(PG8_SA(0, 0), cA, voffA); PG8_STAGE(PG8_SA(0, 1), cA + hstep, voffA);
        if (wr == 1) PG8_BAR;
        PG8_WAIT_V(2); PG8_BAR;
        PG8_STAGE(PG8_SB(1, 0), cB + kstep, voffB); PG8_STAGE(PG8_SA(1, 0), cA + kstep, voffA); PG8_STAGE(PG8_SB(1, 1), cB + hstep + kstep, voffB);
        PG8_WAIT_V(6); PG8_BAR;
    } else {
        PG8_STAGE(PG8_SB(0, 0), cB, voffB); PG8_STAGE(PG8_SA(0, 0), cA, voffA); PG8_STAGE(PG8_SB(0, 1), cB + hstep, voffB); PG8_STAGE(PG8_SA(0, 1), cA + hstep, voffA);
        if (wr == 1) PG8_BAR;
        PG8_WAIT_V(4); PG8_BAR;
        PG8_STAGE(PG8_SB(1, 0), cB + kstep, voffB); PG8_STAGE(PG8_SA(1, 0), cA + kstep, voffA); PG8_STAGE(PG8_SB(1, 1), cB + hstep + kstep, voffB);
        PG8_WAIT_V(6); PG8_BAR;
    }
    for (;;) {
        const bool has_next = S.next(ui + 1, nxt);
        const char* nA = has_next ? (const char*)g.A + (size_t)nxt.pm * tstep : cA; const char* nB = has_next ? (const char*)g.Bt + (size_t)nxt.pn * tstep : cB;
        for (int t = 0; t < nt; t += 2) {
            const bool last = (t == nt - 2);
            const char* a1 = cA + (size_t)(t + 1) * kstep;
            const char* a2 = last ? nA : cA + (size_t)(t + 2) * kstep; const char* b2 = last ? nB : cB + (size_t)(t + 2) * kstep;
            const char* a3 = a2 + kstep; const char* b3 = b2 + kstep;
            if (last && has_next) S.a_ready(nxt);
            if constexpr (SP2) {
            PG8_LDB(B0, 0, 0); PG8_LDB(B1, 0, 1); PG8_SCHED; PG8_LDA(At, 0, 0); PG8_STAGE(PG8_SA(1, 1), a1 + hstep, voffA);
            PG8_WAIT_V(8); PG8_WAIT_L(0); PG8_BAR; PG8_MMA(0, 0, At, B0); PG8_MMA(0, 1, At, B1); PG8_BAR; PG8_SCHED;
            PG8_LDA(At, 0, 1); PG8_STAGE(PG8_SB(0, 0), b2, voffB); PG8_STAGE(PG8_SB(0, 1), b2 + hstep, voffB); PG8_STAGE(PG8_SA(0, 0), a2, voffA);
            PG8_WAIT_V(8); PG8_WAIT_L(0); PG8_BAR; PG8_MMA(1, 0, At, B0); PG8_MMA(1, 1, At, B1); PG8_BAR; PG8_SCHED;
            PG8_LDB(B0, 1, 0); PG8_LDB(B1, 1, 1); PG8_SCHED; PG8_LDA(At, 1, 0); PG8_STAGE(PG8_SA(0, 1), a2 + hstep, voffA);
            PG8_WAIT_V(8); PG8_WAIT_L(0); PG8_BAR; PG8_MMA(0, 0, At, B0); PG8_MMA(0, 1, At, B1); PG8_BAR; PG8_SCHED;
            PG8_LDA(At, 1, 1); PG8_STAGE(PG8_SB(1, 0), b3, voffB); PG8_STAGE(PG8_SB(1, 1), b3 + hstep, voffB); PG8_STAGE(PG8_SA(1, 0), a3, voffA);
            PG8_WAIT_V(8); PG8_WAIT_L(0); PG8_BAR; PG8_MMA(1, 0, At, B0); PG8_MMA(1, 1, At, B1); PG8_BAR; PG8_SCHED;
            } else {
            PG8_LDB(B0, 0, 0); PG8_SCHED; PG8_LDA(At, 0, 0); PG8_STAGE(PG8_SA(1, 1), a1 + hstep, voffA);
            PG8_WAIT_L(8); PG8_BAR; PG8_WAIT_L(0); PG8_MMA(0, 0, At, B0); PG8_BAR; PG8_SCHED;
            PG8_LDB(B1, 0, 1); PG8_STAGE(PG8_SB(0, 0), b2, voffB);
            PG8_BAR; PG8_WAIT_L(0); PG8_MMA(0, 1, At, B1); PG8_BAR;
            PG8_LDA(At, 0, 1); PG8_STAGE(PG8_SA(0, 0), a2, voffA);
            PG8_BAR; PG8_WAIT_L(0); PG8_MMA(1, 0, At, B0); PG8_BAR; PG8_SCHED;
            PG8_STAGE(PG8_SB(0, 1), b2 + hstep, voffB);
            PG8_WAIT_V(6); PG8_BAR; PG8_MMA(1, 1, At, B1); PG8_BAR;
            PG8_LDB(B0, 1, 0); PG8_SCHED; PG8_LDA(At, 1, 0); PG8_STAGE(PG8_SA(0, 1), a2 + hstep, voffA);
            PG8_WAIT_L(8); PG8_BAR; PG8_WAIT_L(0); PG8_MMA(0, 0, At, B0); PG8_BAR; PG8_SCHED;
            PG8_LDB(B1, 1, 1); PG8_STAGE(PG8_SB(1, 0), b3, voffB);
            PG8_BAR; PG8_WAIT_L(0); PG8_MMA(0, 1, At, B1); PG8_BAR;
            PG8_LDA(At, 1, 1); PG8_STAGE(PG8_SA(1, 0), a3, voffA);
            PG8_BAR; PG8_WAIT_L(0); PG8_MMA(1, 0, At, B0); PG8_BAR; PG8_SCHED;
            PG8_STAGE(PG8_SB(1, 1), b3 + hstep, voffB);
            PG8_WAIT_V(6); PG8_BAR; PG8_MMA(1, 1, At, B1); PG8_BAR;
            }
        }
        if constexpr (ALIGN_EPI) { if (wr == 0) PG8_BAR; }
        if constexpr (!Epi::AFTER_DRAIN) { E(acc, cur, wr, wc, fr, fq); S.done(cur); }
        if (!has_next) break;
#pragma unroll
        for (int a = 0; a < 2; ++a)
#pragma unroll
            for (int b = 0; b < 2; ++b)
#pragma unroll
                for (int m = 0; m < 4; ++m)
#pragma unroll
                    for (int n = 0; n < 2; ++n) acc[a][b][m][n] = (f32x4){0.f, 0.f, 0.f, 0.f};
        cur = nxt; cA = nA; cB = nB; ++ui;
        if constexpr (ALIGN_EPI) { if (wr == 1) PG8_BAR; }
    }
    PG8_WAIT_V(0);
    if constexpr (!ALIGN_EPI) { if (wr == 0) PG8_BAR; }
    PG8_BAR;
    if constexpr (Epi::AFTER_DRAIN) { E.fused(acc, cur, wr, wc, fr, fq, lds, wid, lane); S.done(cur); }
#undef PG8_SA
#undef PG8_SB
#undef PG8_STAGE
#undef PG8_LDA
#undef PG8_LDB
#undef PG8_MMA
#undef PG8_WAIT_V
#undef PG8_WAIT_L
#undef PG8_BAR
#undef PG8_SCHED
}
}
#ifndef GEMM_REP
#define GEMM_REP 1
#endif
#ifndef PRO_REP
#define PRO_REP 1
#endif
#ifndef SYNC_EXTRA
#define SYNC_EXTRA 0
#endif
#ifndef SATT_REP
#define SATT_REP 1
#endif
#ifndef GLA_REP
#define GLA_REP 1
#endif
#ifndef ATT_REP
#define ATT_REP 1
#endif

__device__ __forceinline__ void transpose_item(const float* Wsrc, int ldsrc, const float* gain, float scale, bf16* dst, int lddst, LAS float* scr, int lane) {
#pragma unroll 8
    for (int i = 0; i < 32; ++i) { const int kk = 2 * i + (lane >> 5); const float gsc = gain ? gain[kk] * scale : scale; scr[kk * 33 + (lane & 31)] = Wsrc[(size_t)kk * ldsrc + (lane & 31)] * gsc; }
    asm volatile("s_waitcnt lgkmcnt(0)" ::: "memory");
    const int c = lane & 7;
#pragma unroll
    for (int j = 0; j < 4; ++j) { const int n = (lane >> 3) + 8 * j; const LAS float* s = scr + (8 * c) * 33 + n;
        u32x4 o; o.x = pk2(s[0 * 33], s[1 * 33]); o.y = pk2(s[2 * 33], s[3 * 33]); o.z = pk2(s[4 * 33], s[5 * 33]); o.w = pk2(s[6 * 33], s[7 * 33]);
        *(u32x4*)(dst + (size_t)n * lddst + 8 * c) = o; }
    asm volatile("s_waitcnt lgkmcnt(0)" ::: "memory");
}
__device__ __forceinline__ int t5_bucket(int d) {
    if (d < 16) return d;
    int v = 16 + (int)(log((double)d / 16.0) / log(128.0) * 16.0);
    return v < 31 ? v : 31;
}
struct In {
    const float *xp, *xs, *state, *c1, *c2, *c3, *norm_g, *w_in, *w_a2, *b_a, *gon, *w_o_a, *g_kv, *w_kv, *w_q, *w_o_b, *rel_bias, *w_gu, *w_down;
};
__device__ __forceinline__ void p0_prologue(LAS unsigned char* lds, const In& I, unsigned char* ws, float* out, int vcu, int G, int tid) {
    const int lane = tid & 63, wave = tid >> 6;
    LAS float* wa = (LAS float*)lds;
    LAS float* scr = (LAS float*)(lds + 65536 + wave * 8448);
    for (int i = tid; i < 1024 * 16; i += 512) { const int k = i >> 4, r = i & 15; wa[i] = I.w_in[(size_t)k * NIN + NWIN + r] * I.norm_g[k]; }
    __syncthreads();
    const int gw = vcu * NWAVES + wave, NGW = G * NWAVES;
    constexpr int I_WIN = 16 * 96, I_WO = 16 * 32, I_GU = 16 * 176, I_WD = 44 * 32, I_KVQ = 16 * 144;
    constexpr int NITEMS = I_WIN + I_WO + 2 * I_GU + 2 * I_WD + I_KVQ + I_WO;
    for (int it = gw; it < NITEMS; it += NGW) {
        int r = it;
        if (r < I_WIN) { const int kb = r / 96, nb = r % 96, k0 = kb * 64, n0 = nb * 32;
            transpose_item(I.w_in + (size_t)k0 * NIN + n0, NIN, I.norm_g + k0, n0 < 512 ? 0.08838834764831845f : 1.f, (bf16*)(ws + WS_WIN) + (size_t)n0 * 1024 + k0, 1024, scr, lane); continue; }
        r -= I_WIN;
        if (r < I_WO) { const int kb = r / 32, nb = r % 32, k0 = kb * 64, n0 = nb * 32;
            transpose_item(I.w_o_a + (size_t)k0 * 1024 + n0, 1024, nullptr, 1.f, (bf16*)(ws + WS_WOA) + (size_t)n0 * 1024 + k0, 1024, scr, lane); continue; }
        r -= I_WO;
        if (r < 2 * I_GU) { const int l = r / I_GU; r -= l * I_GU; const int kb = r / 176, nb = r % 176, k0 = kb * 64, n0 = nb * 32;
            const int tile = n0 >> 8, j = n0 & 255, src = j < 128 ? tile * 128 + j : FF + tile * 128 + (j - 128);
            transpose_item(I.w_gu + (size_t)l * 1024 * NGU + (size_t)k0 * NGU + src, NGU, I.norm_g + (l * 4 + 2) * 1024 + k0, 1.f, (bf16*)(ws + (l ? WS_WGU1 : WS_WGU0)) + (size_t)n0 * 1024 + k0, 1024, scr, lane); continue; }
        r -= 2 * I_GU;
        if (r < 2 * I_WD) { const int l = r / I_WD; r -= l * I_WD; const int kb = r / 32, nb = r % 32, k0 = kb * 64, n0 = nb * 32;
            transpose_item(I.w_down + (size_t)l * FF * 1024 + (size_t)k0 * 1024 + n0, 1024, nullptr, 1.f, (bf16*)(ws + (l ? WS_WD1 : WS_WD0)) + (size_t)n0 * FF + k0, FF, scr, lane); continue; }
        r -= 2 * I_WD;
        if (r < I_KVQ) { const int kb = r / 144, nb = r % 144, k0 = kb * 64, n0 = nb * 32;
            if (n0 < NKV) transpose_item(I.w_kv + (size_t)k0 * NKV + n0, NKV, I.g_kv + k0, 1.f, (bf16*)(ws + WS_WKVQ) + (size_t)n0 * 1024 + k0, 1024, scr, lane);
            else transpose_item(I.w_q + (size_t)k0 * NQ + (n0 - NKV), NQ, I.norm_g + 4 * 1024 + k0, 0.125f * 1.4426950408889634f, (bf16*)(ws + WS_WKVQ) + (size_t)n0 * 1024 + k0, 1024, scr, lane);
            continue; }
        r -= I_KVQ;
        { const int kb = r / 32, nb = r % 32, k0 = kb * 64, n0 = nb * 32;
            transpose_item(I.w_o_b + (size_t)k0 * 1024 + n0, 1024, nullptr, 1.f, (bf16*)(ws + WS_WOB) + (size_t)n0 * 1024 + k0, 1024, scr, lane); }
    }
    bf16* XB0 = (bf16*)(ws + WS_XB0); float* Abuf = (float*)(ws + WS_ABUF);
    for (int row = gw; row < MT; row += NGW) {
        const float* xr = row < NP ? I.xp + (size_t)row * D : I.xs + (size_t)(row - NP) * D;
        f32x4 v[4]; float ss = 0.f;
#pragma unroll
        for (int j = 0; j < 4; ++j) { v[j] = *(const f32x4*)(xr + 4 * lane + 256 * j); ss += (v[j][0] * v[j][0] + v[j][1] * v[j][1]) + (v[j][2] * v[j][2] + v[j][3] * v[j][3]); }
        const float rstd = rsqrtf(wave_sum(ss) * (1.f / D) + EPS);
        float a[16];
#pragma unroll
        for (int r = 0; r < 16; ++r) a[r] = 0.f;
#pragma unroll
        for (int j = 0; j < 4; ++j) { u32x2 o; o.x = pk2(v[j][0] * rstd, v[j][1] * rstd); o.y = pk2(v[j][2] * rstd, v[j][3] * rstd);
            *(u32x2*)(XB0 + (size_t)row * D + 4 * lane + 256 * j) = o; }
#pragma unroll 1
        for (int j = 0; j < 4; ++j) { const f32x4 xv = *(const f32x4*)(xr + 4 * lane + 256 * j);
#pragma unroll
            for (int i = 0; i < 4; ++i) { const LAS f32x4* w4 = (const LAS f32x4*)(wa + (4 * lane + 256 * j + i) * 16);
#pragma unroll
                for (int q = 0; q < 4; ++q) { const f32x4 w = w4[q]; a[4 * q + 0] += xv[i] * w[0]; a[4 * q + 1] += xv[i] * w[1]; a[4 * q + 2] += xv[i] * w[2]; a[4 * q + 3] += xv[i] * w[3]; } } }
        float mine = 0.f;
#pragma unroll
        for (int r = 0; r < 16; ++r) { const float s = wave_sum(a[r]) * rstd; if (lane == r) mine = s; }
        if (lane < 16) Abuf[(size_t)row * 16 + lane] = mine;
    }
    {
        const size_t gt = (size_t)vcu * 512 + tid, GT = (size_t)G * 512;
#pragma unroll
        for (int g = 0; g < 3; ++g) {
            const int Wg = g == 0 ? 128 : (g == 1 ? 512 : 2048); const float* src = g == 0 ? I.c1 : (g == 1 ? I.c2 : I.c3);
            float* dst = out + (g == 0 ? OFF_W1S : (g == 1 ? OFF_W2S : OFF_W3S));
            const size_t per_b = (size_t)(Wg - 8) * 128;
            const size_t total = per_b * SB;
            for (size_t i = gt; i < total; i += GT) { const size_t b = i / per_b, o = i - b * per_b;
                ((f32x4*)dst)[b * (size_t)Wg * 128 + o] = ((const f32x4*)src)[b * (size_t)Wg * 128 + 8 * 128 + o]; }
        }
    }
    { float* bt = (float*)(ws + WS_BIAS);
      for (int i = vcu * 512 + tid; i < 3 * 16 * NKEYS; i += G * 512) { const int g = i / (16 * NKEYS), hd = (i / NKEYS) % 16, j = i % NKEYS; const int dil = g == 0 ? 1 : (g == 1 ? 4 : 16);
          bt[i] = I.rel_bias[t5_bucket(dil * j) * 48 + g * 16 + hd] * 1.4426950408889634f; } }
}

__device__ __forceinline__ void rownorm_phase(const float* Y, const float* hp_prompt, const float* hp_sample, const float* gain, float* H, bf16* XB, int vcu, int G, int tid) {
    const int lane = tid & 63, wave = tid >> 6; const int gw = vcu * NWAVES + wave, NGW = G * NWAVES;
    f32x4 gv[4];
#pragma unroll
    for (int j = 0; j < 4; ++j) gv[j] = *(const f32x4*)(gain + 4 * lane + 256 * j);
    for (int row = gw; row < MT; row += NGW) {
        const float* yr = Y + (size_t)row * D; const float* hr = row < NP ? hp_prompt + (size_t)row * D : hp_sample + (size_t)(row - NP) * D;
        f32x4 y[4], h[4]; float ss = 0.f;
#pragma unroll
        for (int j = 0; j < 4; ++j) { y[j] = *(const f32x4*)(yr + 4 * lane + 256 * j); h[j] = *(const f32x4*)(hr + 4 * lane + 256 * j); ss += (y[j][0] * y[j][0] + y[j][1] * y[j][1]) + (y[j][2] * y[j][2] + y[j][3] * y[j][3]); }
        const float rstd = rsqrtf(wave_sum(ss) * (1.f / D) + EPS); float s2 = 0.f;
#pragma unroll
        for (int j = 0; j < 4; ++j) { h[j] = h[j] + y[j] * rstd * gv[j]; *(f32x4*)(H + (size_t)row * D + 4 * lane + 256 * j) = h[j]; s2 += (h[j][0] * h[j][0] + h[j][1] * h[j][1]) + (h[j][2] * h[j][2] + h[j][3] * h[j][3]); }
        if (XB) { const float r2 = rsqrtf(wave_sum(s2) * (1.f / D) + EPS);
#pragma unroll
            for (int j = 0; j < 4; ++j) { u32x2 o; o.x = pk2(h[j][0] * r2, h[j][1] * r2); o.y = pk2(h[j][2] * r2, h[j][3] * r2); *(u32x2*)(XB + (size_t)row * D + 4 * lane + 256 * j) = o; } }
    }
}

__device__ __forceinline__ void gla_simple_phase(LAS unsigned char* lds, const bf16* P, const float* Abuf, const In& I, float* out, bf16* XB, int vcu, int G, int tid) {
    LAS float* sq = (LAS float*)lds;
    LAS float* sk = sq + 2048;
    LAS float* sg = sk + 2048;
    LAS float* sv = sg + 2048;
    LAS float* sa = sv + 4096;
    LAS float* so = sa + 256;
    LAS float* sw2 = so + 8192;
    const int lane = tid & 63, wave = tid >> 6, e = tid & 255, dh = tid >> 8;
    for (int u = vcu; u < 192; u += G) {
        int b, h, T, row0; const float* S0; float* Sout;
        if (u < 64) { b = u >> 2; h = u & 3; T = PT; row0 = b * PT; S0 = nullptr; Sout = out + OFF_GLAP + (size_t)(b * 4 + h) * 32768; }
        else { const int su = u - 64; b = su >> 2; h = su & 3; T = ST; row0 = NP + b * ST; S0 = I.state + (size_t)(b * 4 + h) * 32768; Sout = out + OFF_GLAS + (size_t)(b * 4 + h) * 32768; }
        __syncthreads();
        for (int i = tid; i < 2048; i += 512) sw2[i] = I.w_a2[(i >> 7) * 512 + h * 128 + (i & 127)];
        if (tid < 128) sw2[2048 + tid] = I.b_a[h * 128 + tid];
        float S[64];
#pragma unroll
        for (int i = 0; i < 64; ++i) S[i] = S0 ? S0[(size_t)(64 * dh + i) * 256 + e] : 0.f;
        for (int t0 = 0; t0 < T; t0 += 16) {
            const int nb = (T - t0) < 16 ? (T - t0) : 16;
            __syncthreads();
            if (tid < 256) { const int tt = tid >> 4; sa[tid] = tt < nb ? Abuf[(size_t)(row0 + t0 + tt) * 16 + (tid & 15)] : 0.f; }
            __syncthreads();
            for (int idx = tid; idx < 2048; idx += 512) { const int tt = idx >> 7, d = idx & 127;
                if (tt < nb) { float x = sw2[2048 + d];
#pragma unroll
                    for (int r = 0; r < 16; ++r) x += sa[tt * 16 + r] * sw2[r * 128 + d];
                    const float ls = fminf(x, 0.f) - log1pf(expf(-fabsf(x)));
                    sg[idx] = expf(ls * (1.f / 16.f));
                    const bf16* pr = P + (size_t)(row0 + t0 + tt) * NWIN;
                    sq[idx] = bf2f(pr[h * 128 + d]); sk[idx] = bf2f(pr[512 + h * 128 + d]); } }
            for (int idx = tid; idx < 4096; idx += 512) { const int tt = idx >> 8, ee = idx & 255; if (tt < nb) sv[idx] = bf2f(P[(size_t)(row0 + t0 + tt) * NWIN + 1024 + h * 256 + ee]); }
            __syncthreads();
            for (int tt = 0; tt < nb; ++tt) {
                const float ve = sv[tt * 256 + e]; float acc = 0.f;
                const LAS f32x4* g4 = (const LAS f32x4*)(sg + tt * 128 + 64 * dh); const LAS f32x4* k4 = (const LAS f32x4*)(sk + tt * 128 + 64 * dh); const LAS f32x4* q4 = (const LAS f32x4*)(sq + tt * 128 + 64 * dh);
#pragma unroll
                for (int i4 = 0; i4 < 16; ++i4) { const f32x4 gg = g4[i4], kk = k4[i4], qq = q4[i4];
#pragma unroll
                    for (int c = 0; c < 4; ++c) { S[4 * i4 + c] = S[4 * i4 + c] * gg[c] + kk[c] * ve; acc += qq[c] * S[4 * i4 + c]; } }
                so[(tt * 2 + dh) * 256 + e] = acc;
            }
            __syncthreads();
            for (int tt = wave; tt < nb; tt += 8) {
                const int e0 = lane * 4; const f32x4 o0 = *(const LAS f32x4*)(so + (tt * 2 + 0) * 256 + e0), o1 = *(const LAS f32x4*)(so + (tt * 2 + 1) * 256 + e0);
                const f32x4 o = o0 + o1; const float ss = wave_sum((o[0] * o[0] + o[1] * o[1]) + (o[2] * o[2] + o[3] * o[3])); const float rstd = rsqrtf(ss * (1.f / 256.f) + EPS);
                const size_t row = (size_t)(row0 + t0 + tt); const u32x2 rr = *(const u32x2*)(P + row * NWIN + 2048 + h * 256 + e0); const f32x4 gn = *(const f32x4*)(I.gon + e0);
                const float r0 = bflo(rr.x), r1 = bfhi(rr.x), r2 = bflo(rr.y), r3 = bfhi(rr.y);
                u32x2 w; w.x = pk2(o[0] * rstd * gn[0] * silu_f(r0), o[1] * rstd * gn[1] * silu_f(r1)); w.y = pk2(o[2] * rstd * gn[2] * silu_f(r2), o[3] * rstd * gn[3] * silu_f(r3));
                *(u32x2*)(XB + row * D + h * 256 + e0) = w;
            }
        }
#pragma unroll
        for (int i = 0; i < 64; ++i) Sout[(size_t)(64 * dh + i) * 256 + e] = S[i];
    }
}

typedef short bf16x8 __attribute__((ext_vector_type(8)));
typedef short s16x4 __attribute__((ext_vector_type(4)));
typedef float f32x16 __attribute__((ext_vector_type(16)));
__device__ __forceinline__ s16x4 vtr(const LAS unsigned char* p) { return __builtin_bit_cast(s16x4, __builtin_amdgcn_ds_read_tr16_b64_v4i16((LAS s16x4*)p)); }

typedef float f32x4v __attribute__((ext_vector_type(4)));
__device__ __forceinline__ int qk_off(int t, int d) { return t * 272 + d * 2; }
__device__ __forceinline__ int r128_off(int r, int c) { return r * 144 + c * 2; }
__device__ __forceinline__ void gla_mfma_phase(LAS unsigned char* lds, const bf16* P, const float* Abuf, const In& I, float* out, bf16* XB, int vcu, int G, int tid0) {
    LAS unsigned char* QT = lds; LAS unsigned char* KT = lds + 17408; LAS unsigned char* KDT = lds + 34816; LAS unsigned char* AT = lds + 53248;
    LAS float* OST = (LAS float*)lds;
    LAS unsigned char* Vt = lds + 65536;
    LAS float* SA = (LAS float*)(lds + 98304);
    LAS float* TOT = (LAS float*)(lds + 102400);
    LAS float* DL = (LAS float*)(lds + 104448);
    LAS float* GL = (LAS float*)(lds + 104960);
    LAS float* SW2 = (LAS float*)(lds + 137728);
    for (int u = vcu; u < 192; u += G) {
        int b, hh, T, row0; const float* S0; float* Sout;
        if (u < 64) { b = u >> 2; hh = u & 3; T = PT; row0 = b * PT; S0 = nullptr; Sout = out + OFF_GLAP + (size_t)(b * 4 + hh) * 32768; }
        else { const int su = u - 64; b = su >> 2; hh = su & 3; T = ST; row0 = NP + b * ST; S0 = I.state + (size_t)(b * 4 + hh) * 32768; Sout = out + OFF_GLAS + (size_t)(b * 4 + hh) * 32768; }
        int tid = tid0; asm volatile("" : "+v"(tid));
        int lane = tid & 63, w = tid >> 6, r32 = lane & 31, h2 = lane >> 5;
        __syncthreads();
        for (int i = tid; i < 2048; i += 512) SW2[i] = I.w_a2[(i >> 7) * 512 + hh * 128 + (i & 127)];
        if (tid < 128) SW2[2048 + tid] = I.b_a[hh * 128 + tid];
        const f32x4v gn = *(const f32x4v*)(I.gon + 4 * lane);
        f32x16 S[4];
#pragma unroll
        for (int db = 0; db < 4; ++db)
#pragma unroll
            for (int rg = 0; rg < 16; ++rg) S[db][rg] = S0 ? S0[(size_t)(32 * db + (rg & 3) + 8 * (rg >> 2) + 4 * h2) * 256 + 32 * w + r32] : 0.f;
        float pa[2]; u32x4 pv[4], pq[2], pk[2];
#define GLA_PREFETCH(T0_) do { const int nv_ = (T - (T0_)) < 64 ? (T - (T0_)) : 64; const size_t rb_ = (size_t)(row0 + (T0_)); \
            _Pragma("unroll") for (int j_ = 0; j_ < 2; ++j_) { const int i_ = tid + 512 * j_; pa[j_] = (i_ >> 4) < nv_ ? Abuf[(rb_ + (i_ >> 4)) * 16 + (i_ & 15)] : 0.f; } \
            _Pragma("unroll") for (int j_ = 0; j_ < 4; ++j_) { const int q_ = tid + 512 * j_, n_ = q_ >> 5, ch_ = q_ & 31; pv[j_] = (u32x4){0u, 0u, 0u, 0u}; if (n_ < nv_) pv[j_] = *(const u32x4*)(P + (rb_ + n_) * NWIN + 1024 + hh * 256 + ch_ * 8); } \
            _Pragma("unroll") for (int j_ = 0; j_ < 2; ++j_) { const int q_ = tid + 512 * j_, n_ = q_ >> 4, ch_ = q_ & 15; pq[j_] = (u32x4){0u, 0u, 0u, 0u}; pk[j_] = pq[j_]; \
                if (n_ < nv_) { const bf16* s_ = P + (rb_ + n_) * NWIN + hh * 128 + ch_ * 8; pq[j_] = *(const u32x4*)s_; pk[j_] = *(const u32x4*)(s_ + 512); } } } while (0)
        GLA_PREFETCH(0);
#pragma unroll 1
        for (int t0 = 0; t0 < T; t0 += 64) {
            const int nv = (T - t0) < 64 ? (T - t0) : 64; const size_t rbase = (size_t)(row0 + t0);
            tid = tid0; asm volatile("" : "+v"(tid));
            lane = tid & 63; w = tid >> 6; r32 = lane & 31; h2 = lane >> 5; const int d = tid & 127, tq = tid >> 7;
            const int vlane = ((lane >> 4) & 1) * 32 + (lane & 3) * 8 + ((lane & 15) >> 2) * 64;
            __syncthreads();
#pragma unroll
            for (int j = 0; j < 2; ++j) SA[tid + 512 * j] = pa[j];
#pragma unroll
            for (int j = 0; j < 4; ++j) { const int q = tid + 512 * j, n = q >> 5, ch = q & 31; *(LAS u32x4*)(Vt + ((n >> 3) * 8 + (ch >> 2)) * 512 + (n & 7) * 64 + (ch & 3) * 16) = pv[j]; }
#pragma unroll
            for (int j = 0; j < 2; ++j) { const int q = tid + 512 * j, n = q >> 4, ch = q & 15; *(LAS u32x4*)(QT + n * 272 + ch * 16) = pq[j]; *(LAS u32x4*)(KT + n * 272 + ch * 16) = pk[j]; }
            if (t0 + 64 < T) GLA_PREFETCH(t0 + 64);
            __syncthreads();
            float run = 0.f;
#pragma unroll 2
            for (int i = 0; i < 16; ++i) { const int tt = 16 * tq + i; float x = SW2[2048 + d];
                const LAS f32x4v* a4 = (const LAS f32x4v*)(SA + tt * 16);
#pragma unroll
                for (int q = 0; q < 4; ++q) { const f32x4v av = a4[q]; x += av[0] * SW2[(4 * q) * 128 + d] + av[1] * SW2[(4 * q + 1) * 128 + d] + av[2] * SW2[(4 * q + 2) * 128 + d] + av[3] * SW2[(4 * q + 3) * 128 + d]; }
                const float ls = fminf(x, 0.f) - __logf(1.f + __expf(-fabsf(x)));
                run += (tt < nv) ? ls * (1.f / 16.f) : 0.f; GL[tt * 128 + d] = run; }
            TOT[tq * 128 + d] = run;
            __syncthreads();
            float pre = 0.f, blast = 0.f;
#pragma unroll
            for (int q = 0; q < 4; ++q) { const float tv = TOT[q * 128 + d]; blast += tv; if (q < tq) pre += tv; }
            const float dl = __expf(blast);
            if (tq == 0) DL[d] = dl;
            unsigned kdp[8];
#pragma unroll
            for (int i = 0; i < 16; i += 2) {
                const int tt = 16 * tq + i;
                const float q0 = bf2f(*(const LAS unsigned short*)(QT + qk_off(tt, d))), q1 = bf2f(*(const LAS unsigned short*)(QT + qk_off(tt + 1, d)));
                const float k0 = bf2f(*(const LAS unsigned short*)(KT + qk_off(tt, d))), k1 = bf2f(*(const LAS unsigned short*)(KT + qk_off(tt + 1, d)));
                const float b0 = pre + GL[tt * 128 + d], b1 = pre + GL[(tt + 1) * 128 + d];
                const float qt0 = q0 * __expf(b0), qt1 = q1 * __expf(b1), kt0 = k0 * __expf(-b0), kt1 = k1 * __expf(-b1);
                *(LAS unsigned short*)(QT + qk_off(tt, d)) = (unsigned short)(pk2(qt0, 0.f) & 0xffffu); *(LAS unsigned short*)(QT + qk_off(tt + 1, d)) = (unsigned short)(pk2(qt1, 0.f) & 0xffffu);
                *(LAS unsigned short*)(KT + qk_off(tt, d)) = (unsigned short)(pk2(kt0, 0.f) & 0xffffu); *(LAS unsigned short*)(KT + qk_off(tt + 1, d)) = (unsigned short)(pk2(kt1, 0.f) & 0xffffu);
                kdp[i >> 1] = pk2(kt0 * dl, kt1 * dl); }
            { u32x4 k0 = {kdp[0], kdp[1], kdp[2], kdp[3]}, k1 = {kdp[4], kdp[5], kdp[6], kdp[7]};
              *(LAS u32x4*)(KDT + r128_off(d, 16 * tq)) = k0; *(LAS u32x4*)(KDT + r128_off(d, 16 * tq + 8)) = k1; }
            __syncthreads();
#pragma unroll
            for (int tt2 = 0; tt2 < 2; ++tt2) { const int Tl = 2 * w + tt2, ti = Tl >> 2, tj = Tl & 3; const int lr = lane & 15, kq = lane >> 4;
                f32x4v acc = {0.f, 0.f, 0.f, 0.f};
                if (ti >= tj) {
#pragma unroll
                    for (int ks = 0; ks < 4; ++ks) { const bf16x8 a = *(const LAS bf16x8*)(QT + qk_off(16 * ti + lr, 32 * ks + 8 * kq)); const bf16x8 bb = *(const LAS bf16x8*)(KT + qk_off(16 * tj + lr, 32 * ks + 8 * kq));
                        acc = __builtin_amdgcn_mfma_f32_16x16x32_bf16(a, bb, acc, 0, 0, 0); } }
#pragma unroll
                for (int rg = 0; rg < 4; ++rg) { const int i = 16 * ti + 4 * kq + rg, j = 16 * tj + lr; const float v = (j <= i) ? acc[rg] : 0.f;
                    *(LAS unsigned short*)(AT + r128_off(i, j)) = (unsigned short)(pk2(v, 0.f) & 0xffffu); } }
            __syncthreads();
            f32x16 o0 = {0.f, 0.f, 0.f, 0.f, 0.f, 0.f, 0.f, 0.f, 0.f, 0.f, 0.f, 0.f, 0.f, 0.f, 0.f, 0.f}, o1 = o0;
#pragma unroll
            for (int db = 0; db < 4; ++db)
#pragma unroll
                for (int s = 0; s < 2; ++s) {
                    u32x4 sw; sw.x = pk2(S[db][8 * s + 0], S[db][8 * s + 1]); sw.y = pk2(S[db][8 * s + 2], S[db][8 * s + 3]); sw.z = pk2(S[db][8 * s + 4], S[db][8 * s + 5]); sw.w = pk2(S[db][8 * s + 6], S[db][8 * s + 7]);
                    const bf16x8 sb = __builtin_bit_cast(bf16x8, sw);
                    const int dd = 32 * db + 16 * s + 4 * h2;
                    const u32x2 a00 = *(const LAS u32x2*)(QT + qk_off(r32, dd)), a01 = *(const LAS u32x2*)(QT + qk_off(r32, dd + 8));
                    const u32x2 a10 = *(const LAS u32x2*)(QT + qk_off(32 + r32, dd)), a11 = *(const LAS u32x2*)(QT + qk_off(32 + r32, dd + 8));
                    const u32x4 A0 = {a00.x, a00.y, a01.x, a01.y}, A1 = {a10.x, a10.y, a11.x, a11.y};
                    o0 = __builtin_amdgcn_mfma_f32_32x32x16_bf16(__builtin_bit_cast(bf16x8, A0), sb, o0, 0, 0, 0);
                    o1 = __builtin_amdgcn_mfma_f32_32x32x16_bf16(__builtin_bit_cast(bf16x8, A1), sb, o1, 0, 0, 0);
                    __builtin_amdgcn_sched_barrier(0);
                }
            bf16x8 vf[4];
#pragma unroll
            for (int ks = 0; ks < 4; ++ks) { const LAS unsigned char* vb = Vt + ((2 * ks + h2) * 8 + w) * 512 + vlane; const s16x4 x0 = vtr(vb), x1 = vtr(vb + 256);
                vf[ks] = (bf16x8){x0[0], x0[1], x0[2], x0[3], x1[0], x1[1], x1[2], x1[3]}; }
#pragma unroll
            for (int ks = 0; ks < 4; ++ks) {
                if (ks < 2) { const bf16x8 a = *(const LAS bf16x8*)(AT + r128_off(r32, 16 * ks + 8 * h2)); o0 = __builtin_amdgcn_mfma_f32_32x32x16_bf16(a, vf[ks], o0, 0, 0, 0); }
                { const bf16x8 a = *(const LAS bf16x8*)(AT + r128_off(32 + r32, 16 * ks + 8 * h2)); o1 = __builtin_amdgcn_mfma_f32_32x32x16_bf16(a, vf[ks], o1, 0, 0, 0); } }
            __builtin_amdgcn_sched_barrier(0);
#pragma unroll
            for (int db = 0; db < 4; ++db) {
                __builtin_amdgcn_sched_barrier(0);
#pragma unroll
                for (int rq = 0; rq < 4; ++rq) { const f32x4v dv = *(const LAS f32x4v*)(DL + 32 * db + 8 * rq + 4 * h2);
                    S[db][4 * rq + 0] *= dv[0]; S[db][4 * rq + 1] *= dv[1]; S[db][4 * rq + 2] *= dv[2]; S[db][4 * rq + 3] *= dv[3]; }
#pragma unroll
                for (int ks = 0; ks < 4; ++ks) { const bf16x8 a = *(const LAS bf16x8*)(KDT + r128_off(32 * db + r32, 16 * ks + 8 * h2)); S[db] = __builtin_amdgcn_mfma_f32_32x32x16_bf16(a, vf[ks], S[db], 0, 0, 0); } }
            __syncthreads();
#pragma unroll
            for (int rg = 0; rg < 16; ++rg) { const int i = (rg & 3) + 8 * (rg >> 2) + 4 * h2; OST[i * 256 + 32 * w + r32] = o0[rg]; OST[(32 + i) * 256 + 32 * w + r32] = o1[rg]; }
            __syncthreads();
            u32x2 rpre[8];
#pragma unroll
            for (int ii = 0; ii < 8; ++ii) { const int i = 8 * w + ii; rpre[ii] = (u32x2){0u, 0u}; if (i < nv) rpre[ii] = *(const u32x2*)(P + (rbase + i) * NWIN + 2048 + hh * 256 + 4 * lane); }
#pragma unroll
            for (int ii = 0; ii < 8; ++ii) { const int i = 8 * w + ii;
                if (i < nv) {
                    const f32x4v o = *(const LAS f32x4v*)(OST + i * 256 + 4 * lane); const float ss = wave_sum((o[0] * o[0] + o[1] * o[1]) + (o[2] * o[2] + o[3] * o[3])); const float rstd = rsqrtf(ss * (1.f / 256.f) + EPS);
                    const size_t row = rbase + i; const u32x2 rr = rpre[ii];
                    u32x2 ww; ww.x = pk2(o[0] * rstd * gn[0] * silu_f(bflo(rr.x)), o[1] * rstd * gn[1] * silu_f(bfhi(rr.x))); ww.y = pk2(o[2] * rstd * gn[2] * silu_f(bflo(rr.y)), o[3] * rstd * gn[3] * silu_f(bfhi(rr.y)));
                    *(u32x2*)(XB + row * D + hh * 256 + 4 * lane) = ww; } }
        }
        tid = tid0; lane = tid & 63; w = tid >> 6; r32 = lane & 31; h2 = lane >> 5;
#pragma unroll
        for (int db = 0; db < 4; ++db)
#pragma unroll
            for (int rg = 0; rg < 16; ++rg) Sout[(size_t)(32 * db + (rg & 3) + 8 * (rg >> 2) + 4 * h2) * 256 + 32 * w + r32] = S[db][rg];
    }
    __syncthreads();
}

__device__ __forceinline__ void attn_simple_phase(LAS unsigned char* lds, const bf16* Qb, const bf16* KV, const In& I, const float* biasT, bf16* XB, int vcu, int G, int tid, int row_lo, int row_hi) {
    const int lane = tid & 63, wave = tid >> 6; const int gw = vcu * NWAVES + wave, NGW = G * NWAVES;
    LAS float* sqw = (LAS float*)(lds + wave * 10240);
    LAS float* sp = sqw + 256;
    for (int task = gw + row_lo * 4; task < row_hi * 4; task += NGW) {
        const int row = task >> 2, kvh = task & 3; const bool prompt = row < NP;
        const int b = prompt ? (row >> 11) : ((row - NP) >> 3), t = prompt ? (row & 2047) : ((row - NP) & 7);
#pragma unroll
        for (int g = 0; g < 3; ++g) {
            const int dil = g == 0 ? 1 : (g == 1 ? 4 : 16), Wg = g == 0 ? 128 : (g == 1 ? 512 : 2048); const float* cache = g == 0 ? I.c1 : (g == 1 ? I.c2 : I.c3);
            asm volatile("s_waitcnt lgkmcnt(0)" ::: "memory");
#pragma unroll
            for (int i = 0; i < 4; ++i) sqw[lane + 64 * i] = bf2f(Qb[(size_t)row * NQ + g * 1024 + kvh * 256 + lane + 64 * i]);
            asm volatile("s_waitcnt lgkmcnt(0)" ::: "memory");
#pragma unroll 1
            for (int rd = 0; rd < 3; ++rd) {
                const int j = rd * 64 + lane; bool valid = j < NKEYS; const bf16* kb = nullptr; const float* kf = nullptr;
                if (prompt) { const int idx = t - dil * j; valid = valid && idx >= 0; kb = KV + (size_t)(b * PT + (idx < 0 ? 0 : idx)) * NKV + g * 512 + kvh * 64; }
                else { const int idf = Wg + t - dil * j; if (idf >= Wg) kb = KV + (size_t)(NP + b * ST + (idf - Wg)) * NKV + g * 512 + kvh * 64; else kf = cache + ((size_t)(b * Wg + (idf < 0 ? 0 : idf)) * 2) * 256 + kvh * 64; }
                float d0 = 0.f, d1 = 0.f, d2 = 0.f, d3 = 0.f;
                if (valid) {
#pragma unroll 1
                    for (int c = 0; c < 8; ++c) { float kv[8];
                        if (kb) { const u32x4 w = *(const u32x4*)(kb + c * 8); kv[0] = bflo(w.x); kv[1] = bfhi(w.x); kv[2] = bflo(w.y); kv[3] = bfhi(w.y); kv[4] = bflo(w.z); kv[5] = bfhi(w.z); kv[6] = bflo(w.w); kv[7] = bfhi(w.w); }
                        else { const f32x4 w0 = *(const f32x4*)(kf + c * 8), w1 = *(const f32x4*)(kf + c * 8 + 4); kv[0] = w0[0]; kv[1] = w0[1]; kv[2] = w0[2]; kv[3] = w0[3]; kv[4] = w1[0]; kv[5] = w1[1]; kv[6] = w1[2]; kv[7] = w1[3]; }
#pragma unroll
                        for (int i = 0; i < 8; ++i) { d0 += sqw[c * 8 + i] * kv[i]; d1 += sqw[64 + c * 8 + i] * kv[i]; d2 += sqw[128 + c * 8 + i] * kv[i]; d3 += sqw[192 + c * 8 + i] * kv[i]; } }
                }
                const float* bt = biasT + (size_t)(g * 16 + kvh * 4) * NKEYS + (j < NKEYS ? j : 0);
                sp[(0 * 3 + g) * 192 + j] = valid ? d0 + bt[0] : -INFINITY; sp[(1 * 3 + g) * 192 + j] = valid ? d1 + bt[NKEYS] : -INFINITY;
                sp[(2 * 3 + g) * 192 + j] = valid ? d2 + bt[2 * NKEYS] : -INFINITY; sp[(3 * 3 + g) * 192 + j] = valid ? d3 + bt[3 * NKEYS] : -INFINITY;
            }
        }
        asm volatile("s_waitcnt lgkmcnt(0)" ::: "memory");
        float linv[4];
#pragma unroll
        for (int qq = 0; qq < 4; ++qq) {
            float m = -INFINITY;
#pragma unroll 1
            for (int i = 0; i < 9; ++i) m = fmaxf(m, sp[qq * 576 + i * 64 + lane]);
            m = wave_max(m); float l = 0.f;
#pragma unroll 1
            for (int i = 0; i < 9; ++i) { const float p = exp2f(sp[qq * 576 + i * 64 + lane] - m); l += p; sp[qq * 576 + i * 64 + lane] = p; }
            linv[qq] = 1.f / wave_sum(l);
        }
        asm volatile("s_waitcnt lgkmcnt(0)" ::: "memory");
        float o0 = 0.f, o1 = 0.f, o2 = 0.f, o3 = 0.f;
#pragma unroll
        for (int g = 0; g < 3; ++g) {
            const int dil = g == 0 ? 1 : (g == 1 ? 4 : 16), Wg = g == 0 ? 128 : (g == 1 ? 512 : 2048); const float* cache = g == 0 ? I.c1 : (g == 1 ? I.c2 : I.c3);
#pragma unroll 2
            for (int j = 0; j < NKEYS; ++j) {
                float v;
                if (prompt) { const int idx = t - dil * j; if (idx < 0) break; v = bf2f(KV[(size_t)(b * PT + idx) * NKV + g * 512 + 256 + kvh * 64 + lane]); }
                else { const int idf = Wg + t - dil * j; if (idf >= Wg) v = bf2f(KV[(size_t)(NP + b * ST + (idf - Wg)) * NKV + g * 512 + 256 + kvh * 64 + lane]); else v = cache[((size_t)(b * Wg + idf) * 2 + 1) * 256 + kvh * 64 + lane]; }
                o0 += sp[(0 * 3 + g) * 192 + j] * v; o1 += sp[(1 * 3 + g) * 192 + j] * v; o2 += sp[(2 * 3 + g) * 192 + j] * v; o3 += sp[(3 * 3 + g) * 192 + j] * v;
            }
        }
        bf16* orow = XB + (size_t)row * D + kvh * 256 + lane;
        orow[0] = (bf16)(pk2(o0 * linv[0], 0.f) & 0xffffu); orow[64] = (bf16)(pk2(o1 * linv[1], 0.f) & 0xffffu); orow[128] = (bf16)(pk2(o2 * linv[2], 0.f) & 0xffffu); orow[192] = (bf16)(pk2(o3 * linv[3], 0.f) & 0xffffu);
    }
}


__device__ __forceinline__ void attn_mfma_phase(LAS unsigned char* lds, const bf16* Qb, const bf16* KV, const float* biasT, bf16* SCR, float* LST, bf16* XB, int vcu, int G, int tid) {
    const int lane = tid & 63, wave = tid >> 6, r32 = lane & 31, h = lane >> 5, hq = wave & 3, p = wave >> 2, ltid = tid & 255;
    LAS unsigned char* Kt = lds + p * 20480;
    LAS unsigned char* Vt = lds + 40960 + p * 20480;
    LAS float* sbias = (LAS float*)(lds + 81920);
    const int vlane = ((lane >> 4) & 1) * 32 + (lane & 3) * 8 + (4 * h + ((lane & 15) >> 2)) * 64;
    for (int u = vcu; u < 256; u += G) {
        const int b = u >> 4, kvh = (u >> 2) & 3, blk = u & 3, T0 = blk * 512, hd = kvh * 4 + hq;
#pragma unroll 1
        for (int gi = 0; gi < 3; ++gi) {
            const int g = 2 - gi, dsh = 2 * g, dil = 1 << dsh, tsh = 4 - dsh;
            __syncthreads();
            for (int i = tid; i < 768; i += 512) { const int hh = i / 192, j = i % 192 - 32; sbias[i] = (j >= 0 && j <= 128) ? biasT[(size_t)(g * 16 + kvh * 4 + hh) * NKEYS + j] : -INFINITY; }
#pragma unroll 1
            for (int round = 0; round < 8; ++round) {
                const int tau = 2 * round + p, s = tau >> tsh, c = tau & ((1 << tsh) - 1), ifirst = (T0 >> dsh) + 32 * c;
                __syncthreads();
                for (int q = ltid; q < 1280; q += 256) { const int n = q >> 3, ch = q & 7, i = ifirst - 128 + n;
                    u32x4 kx = {0u, 0u, 0u, 0u}, vx = {0u, 0u, 0u, 0u};
                    if (i >= 0) { const bf16* src = KV + (size_t)(b * PT + (i << dsh) + s) * NKV + g * 512 + kvh * 64 + ch * 8; kx = *(const u32x4*)src; vx = *(const u32x4*)(src + 256); }
                    *(LAS u32x4*)(Kt + (ch * 160 + n) * 16) = kx;
                    *(LAS u32x4*)(Vt + ((n >> 3) * 2 + (ch >> 2)) * 512 + (n & 7) * 64 + (ch & 3) * 16) = vx; }
                __syncthreads();
                const int token = T0 + ((32 * c + r32) << dsh) + s; const size_t qrow = (size_t)(b * PT + token);
                bf16x8 qf[4];
#pragma unroll
                for (int ks = 0; ks < 4; ++ks) qf[ks] = *(const bf16x8*)(Qb + qrow * NQ + g * 1024 + hd * 64 + 16 * ks + 8 * h);
                f32x16 S[5]; float m = -INFINITY;
#pragma unroll
                for (int kc = 0; kc < 5; ++kc) {
                    if (ifirst - 128 + 32 * kc >= 0) {
                        f32x16 acc = {0.f, 0.f, 0.f, 0.f, 0.f, 0.f, 0.f, 0.f, 0.f, 0.f, 0.f, 0.f, 0.f, 0.f, 0.f, 0.f};
#pragma unroll
                        for (int ks = 0; ks < 4; ++ks) { const bf16x8 a = *(const LAS bf16x8*)(Kt + ((2 * ks + h) * 160 + 32 * kc + r32) * 16); acc = __builtin_amdgcn_mfma_f32_32x32x16_bf16(a, qf[ks], acc, 0, 0, 0); }
                        const LAS float* bp = sbias + hq * 192 + (160 - 32 * kc + r32 - 4 * h);
#pragma unroll
                        for (int rg = 0; rg < 16; ++rg) { acc[rg] += bp[-((rg & 3) + 8 * (rg >> 2))]; m = fmaxf(m, acc[rg]); }
                        S[kc] = acc;
                    } else {
#pragma unroll
                        for (int rg = 0; rg < 16; ++rg) S[kc][rg] = -INFINITY;
                    }
                }
                m = fmaxf(m, __shfl_xor(m, 32));
                float l = 0.f;
#pragma unroll
                for (int kc = 0; kc < 5; ++kc)
#pragma unroll
                    for (int rg = 0; rg < 16; ++rg) { const float pv = __builtin_amdgcn_exp2f(S[kc][rg] - m); l += pv; S[kc][rg] = pv; }
                l += __shfl_xor(l, 32);
                f32x16 O0 = {0.f, 0.f, 0.f, 0.f, 0.f, 0.f, 0.f, 0.f, 0.f, 0.f, 0.f, 0.f, 0.f, 0.f, 0.f, 0.f}, O1 = O0;
#pragma unroll
                for (int kc = 0; kc < 5; ++kc) {
                    if (ifirst - 128 + 32 * kc >= 0) {
#pragma unroll
                        for (int s2 = 0; s2 < 2; ++s2) {
                            u32x4 pw; pw.x = pk2(S[kc][8 * s2 + 0], S[kc][8 * s2 + 1]); pw.y = pk2(S[kc][8 * s2 + 2], S[kc][8 * s2 + 3]); pw.z = pk2(S[kc][8 * s2 + 4], S[kc][8 * s2 + 5]); pw.w = pk2(S[kc][8 * s2 + 6], S[kc][8 * s2 + 7]);
                            const bf16x8 pb = __builtin_bit_cast(bf16x8, pw);
                            const LAS unsigned char* vb = Vt + ((4 * kc + 2 * s2) * 2) * 512 + vlane;
                            const s16x4 a0 = vtr(vb), a1 = vtr(vb + 1024), c0 = vtr(vb + 512), c1 = vtr(vb + 1536);
                            const bf16x8 va = {a0[0], a0[1], a0[2], a0[3], a1[0], a1[1], a1[2], a1[3]}, vc = {c0[0], c0[1], c0[2], c0[3], c1[0], c1[1], c1[2], c1[3]};
                            O0 = __builtin_amdgcn_mfma_f32_32x32x16_bf16(va, pb, O0, 0, 0, 0);
                            O1 = __builtin_amdgcn_mfma_f32_32x32x16_bf16(vc, pb, O1, 0, 0, 0);
                        }
                    }
                }
                bf16* srow = SCR + qrow * D + hd * 64 + 4 * h; float* lrow = LST + (qrow * 16 + hd) * 2;
                if (gi > 0) {
                    const float mp = lrow[0], lp = lrow[1]; const float mn = fmaxf(m, mp), fa = exp2f(mp - mn), fb = exp2f(m - mn);
                    l = l * fb + lp * fa; m = mn;
#pragma unroll
                    for (int rq = 0; rq < 4; ++rq) { const u32x2 w0 = *(const u32x2*)(srow + 8 * rq), w1 = *(const u32x2*)(srow + 32 + 8 * rq);
                        O0[4 * rq + 0] = O0[4 * rq + 0] * fb + bflo(w0.x) * fa; O0[4 * rq + 1] = O0[4 * rq + 1] * fb + bfhi(w0.x) * fa; O0[4 * rq + 2] = O0[4 * rq + 2] * fb + bflo(w0.y) * fa; O0[4 * rq + 3] = O0[4 * rq + 3] * fb + bfhi(w0.y) * fa;
                        O1[4 * rq + 0] = O1[4 * rq + 0] * fb + bflo(w1.x) * fa; O1[4 * rq + 1] = O1[4 * rq + 1] * fb + bfhi(w1.x) * fa; O1[4 * rq + 2] = O1[4 * rq + 2] * fb + bflo(w1.y) * fa; O1[4 * rq + 3] = O1[4 * rq + 3] * fb + bfhi(w1.y) * fa; }
                }
                if (gi < 2) {
                    if (h == 0) { lrow[0] = m; lrow[1] = l; }
#pragma unroll
                    for (int rq = 0; rq < 4; ++rq) { u32x2 w0, w1; w0.x = pk2(O0[4 * rq], O0[4 * rq + 1]); w0.y = pk2(O0[4 * rq + 2], O0[4 * rq + 3]); w1.x = pk2(O1[4 * rq], O1[4 * rq + 1]); w1.y = pk2(O1[4 * rq + 2], O1[4 * rq + 3]);
                        *(u32x2*)(srow + 8 * rq) = w0; *(u32x2*)(srow + 32 + 8 * rq) = w1; }
                } else {
                    const float li = 1.f / l; bf16* orow = XB + qrow * D + hd * 64 + 4 * h;
#pragma unroll
                    for (int rq = 0; rq < 4; ++rq) { u32x2 w0, w1; w0.x = pk2(O0[4 * rq] * li, O0[4 * rq + 1] * li); w0.y = pk2(O0[4 * rq + 2] * li, O0[4 * rq + 3] * li); w1.x = pk2(O1[4 * rq] * li, O1[4 * rq + 1] * li); w1.y = pk2(O1[4 * rq + 2] * li, O1[4 * rq + 3] * li);
                        *(u32x2*)(orow + 8 * rq) = w0; *(u32x2*)(orow + 32 + 8 * rq) = w1; }
                }
            }
        }
    }
    __syncthreads();
}

#define XB_TMO      128
#define XB_XCNT(j)  (256  + 64 * (j))
#define XB_XSUB(j)  (1280 + 64 * (j))
#define XB_XGEN(j)  (2304 + 64 * (j))
#define XB_TOP      3328
#define XB_TOPGEN   3392
#define XCD_BAR_WORDS 3456
#define XB_SPIN_CAP (1u << 18)

__device__ __forceinline__ unsigned xb_ld(unsigned* p)              { return __hip_atomic_load(p, __ATOMIC_RELAXED, __HIP_MEMORY_SCOPE_AGENT); }
__device__ __forceinline__ unsigned xb_add(unsigned* p, unsigned v) { return __hip_atomic_fetch_add(p, v, __ATOMIC_RELAXED, __HIP_MEMORY_SCOPE_AGENT); }
__device__ __forceinline__ unsigned xb_xcc_id() { return (unsigned)__builtin_amdgcn_s_getreg((3 << 11) | 20) & 0xFu; }
#define XB_SPIN(cond, bar) do { unsigned _sp = 0; while (cond) { __builtin_amdgcn_s_sleep(1); \
    if ((++_sp & 255u) == 0u) { if (xb_ld(&(bar)[XB_TMO])) break; if (_sp > XB_SPIN_CAP) { atomicAdd(&(bar)[XB_TMO], 1u); break; } } } } while (0)

struct XcdBarrier {
    unsigned* bar; unsigned x;
    volatile LAS unsigned* st;
};

__device__ __forceinline__ XcdBarrier xcd_barrier_post(unsigned* bar, volatile LAS unsigned* st) {
    XcdBarrier b; b.bar = bar; b.x = xb_xcc_id(); b.st = st;
    if (threadIdx.x == 0) (void)xb_add(&bar[XB_XCNT(b.x)], 1u);
    return b;
}
__device__ __forceinline__ void xcd_barrier_complete(unsigned* bar, unsigned x, unsigned& nloc, unsigned& nx) {
    const unsigned G = gridDim.x * gridDim.y * gridDim.z;
    unsigned sum, cnt, mine, sp = 0u;
    for (;;) {
        sum = 0u; cnt = 0u; mine = 0u;
#pragma unroll
        for (unsigned j = 0; j < 16; ++j) { const unsigned c = xb_ld(&bar[XB_XCNT(j)]); sum += c; cnt += (c > 0u) ? 1u : 0u; mine = (j == x) ? c : mine; }
        if (sum == G) break;
        __builtin_amdgcn_s_sleep(1);
        if ((++sp & 255u) == 0u) { if (xb_ld(&bar[XB_TMO])) break; if (sp > XB_SPIN_CAP) { atomicAdd(&bar[XB_TMO], 1u); break; } }
    }
    nloc = mine > 0u ? mine : 1u; nx = cnt > 0u ? cnt : 1u;
}

__device__ __forceinline__ void xcd_barrier(const XcdBarrier& b) {
    asm volatile("s_waitcnt vmcnt(0)" ::: "memory");
    __syncthreads();
    if (threadIdx.x == 0) {
        unsigned* bar = b.bar;
        __builtin_amdgcn_s_waitcnt(0);
        unsigned nloc = b.st[0], nx = b.st[1];
        if (nloc == 0u) { xcd_barrier_complete(bar, b.x, nloc, nx); b.st[0] = nloc; b.st[1] = nx; }
        const unsigned old = xb_add(&bar[XB_XSUB(b.x)], 1u);
        const unsigned gen = old / nloc;
        if (old + 1u == (gen + 1u) * nloc) {
            __builtin_amdgcn_fence(__ATOMIC_RELEASE, "agent");
            asm volatile("s_waitcnt vmcnt(0)" ::: "memory");
            const unsigned og = xb_add(&bar[XB_TOP], 1u);
            const unsigned tg = og / nx;
            if (og + 1u == (tg + 1u) * nx) xb_add(&bar[XB_TOPGEN], 1u);
            else XB_SPIN(xb_ld(&bar[XB_TOPGEN]) == tg, bar);
            __builtin_amdgcn_fence(__ATOMIC_ACQUIRE, "agent");
            xb_add(&bar[XB_XGEN(b.x)], 1u);
            asm volatile("s_waitcnt vmcnt(0)" ::: "memory");
        } else {
            XB_SPIN(xb_ld(&bar[XB_XGEN(b.x)]) == gen, bar);
            __builtin_amdgcn_fence(__ATOMIC_ACQUIRE, "agent");
            asm volatile("s_waitcnt vmcnt(0)" ::: "memory");
        }
    }
    __syncthreads();
}

struct Args { const float* in[19]; float* out; unsigned char* ws; int ph_lo, ph_hi; };
__global__ void __launch_bounds__(NWAVES * 64, 2) fwd(Args a) {
    extern __shared__ __attribute__((aligned(16))) unsigned char lds_raw[];
    LAS unsigned char* lds = (LAS unsigned char*)lds_raw;
    cg::grid_group grid = cg::this_grid();
    const int tid = threadIdx.x, G = gridDim.x; const int bx = blockIdx.x; const int vcu = (G % 8 == 0) ? (bx % 8) * (G / 8) + bx / 8 : bx;
    In I; I.xp = a.in[0]; I.xs = a.in[1]; I.state = a.in[2]; I.c1 = a.in[3]; I.c2 = a.in[4]; I.c3 = a.in[5]; I.norm_g = a.in[6]; I.w_in = a.in[7]; I.w_a2 = a.in[8]; I.b_a = a.in[9]; I.gon = a.in[10];
    I.w_o_a = a.in[11]; I.g_kv = a.in[12]; I.w_kv = a.in[13]; I.w_q = a.in[14]; I.w_o_b = a.in[15]; I.rel_bias = a.in[16]; I.w_gu = a.in[17]; I.w_down = a.in[18];
    unsigned char* ws = a.ws; float* out = a.out;
    bf16* XB0 = (bf16*)(ws + WS_XB0); bf16* XB1 = (bf16*)(ws + WS_XB1); bf16* BIG = (bf16*)(ws + WS_BIG); float* Y = (float*)(ws + WS_YKV); bf16* KVb = (bf16*)(ws + WS_YKV);
    float* Abuf = (float*)(ws + WS_ABUF); float* biasT = (float*)(ws + WS_BIAS); float* LST = (float*)(ws + WS_LST); float* H = out;
    const int lo = a.ph_lo, hi = a.ph_hi;
    volatile LAS unsigned* MISC = (volatile LAS unsigned*)(lds + LDS_BYTES - 512);
    if (tid < 128) MISC[tid] = 0u;
    __syncthreads();
    XcdBarrier bar = xcd_barrier_post((unsigned*)(ws + WS_CTL) + 1024, MISC + 8);
#define IN(k) (lo <= (k) && (k) < hi)
#define SEAM(k) do { if (IN(k) && IN((k) + 1)) { if ((k) == 0) grid.sync(); else xcd_barrier(bar); } } while (0)

    if (IN(0)) { for (int rep_ = 0; rep_ < PRO_REP; ++rep_) { p0_prologue(lds, I, ws, out, vcu, G, tid); __syncthreads(); } } SEAM(0);
    for (int rep_ = 0; rep_ < SYNC_EXTRA; ++rep_) grid.sync();
    if (IN(1)) { pg8::Gemm g{XB0, (const bf16*)(ws + WS_WIN), MT, NWIN, D}; pg8::StaticOrder S; S.init(MT, NWIN, G, bx); pg8::EpiBf16 E{BIG, NWIN};
                 pg8::gemm_phase<pg8::EpiBf16, pg8::StaticOrder, true, true>(lds, g, S, E); } SEAM(1);
    if (IN(2)) { for (int rep_ = 0; rep_ < GLA_REP; ++rep_) gla_mfma_phase(lds, BIG, Abuf, I, out, XB0, vcu, G, tid); } SEAM(2);
    if (IN(3)) { pg8::Gemm g{XB0, (const bf16*)(ws + WS_WOA), MT, D, D}; pg8::StaticOrder S; S.init(MT, D, G, bx); pg8::EpiF32 E{Y, D};
                 pg8::gemm_phase<pg8::EpiF32, pg8::StaticOrder, true, true>(lds, g, S, E); } SEAM(3);
    if (IN(4)) { rownorm_phase(Y, I.xp, I.xs, I.norm_g + 1 * 1024, H, XB1, vcu, G, tid); } SEAM(4);
    if (IN(5)) { pg8::Gemm g{XB1, (const bf16*)(ws + WS_WGU0), MT, NGU, D}; pg8::StaticOrder S; S.init(MT, NGU, G, bx); pg8::EpiSwiGLU E{BIG, FF};
                 pg8::gemm_phase<pg8::EpiSwiGLU, pg8::StaticOrder, true, true>(lds, g, S, E); } SEAM(5);
    if (IN(6)) { pg8::Gemm g{BIG, (const bf16*)(ws + WS_WD0), MT, D, FF}; pg8::StaticOrder S; S.init(MT, D, G, bx); pg8::EpiF32 E{Y, D};
                 pg8::gemm_phase<pg8::EpiF32, pg8::StaticOrder, true, true>(lds, g, S, E); } SEAM(6);
    if (IN(7)) { rownorm_phase(Y, H, H + (size_t)NP * D, I.norm_g + 3 * 1024, H, XB0, vcu, G, tid); } SEAM(7);
    if (IN(8)) { pg8::Gemm g{XB0, (const bf16*)(ws + WS_WKVQ), MT, NKVQ, D}; pg8::StaticOrder S; S.init(MT, NKVQ, G, bx); pg8::EpiKVQ E{KVb, BIG, out};
                 pg8::gemm_phase<pg8::EpiKVQ, pg8::StaticOrder, true, true>(lds, g, S, E); } SEAM(8);
    if (IN(9)) { for (int rep_ = 0; rep_ < ATT_REP; ++rep_) attn_mfma_phase(lds, BIG, KVb, biasT, XB0, LST, XB1, vcu, G, tid); for (int rep_ = 0; rep_ < SATT_REP; ++rep_) { attn_simple_phase(lds, BIG, KVb, I, biasT, XB1, vcu, G, tid, NP, MT); __syncthreads(); } } SEAM(9);
    if (IN(10)) { pg8::Gemm g{XB1, (const bf16*)(ws + WS_WOB), MT, D, D}; pg8::StaticOrder S; S.init(MT, D, G, bx); pg8::EpiF32 E{Y, D};
                  pg8::gemm_phase<pg8::EpiF32, pg8::StaticOrder, true, true>(lds, g, S, E); } SEAM(10);
    if (IN(11)) { rownorm_phase(Y, H, H + (size_t)NP * D, I.norm_g + 5 * 1024, H, XB0, vcu, G, tid); } SEAM(11);
    if (IN(12)) { pg8::Gemm g{XB0, (const bf16*)(ws + WS_WGU1), MT, NGU, D}; pg8::StaticOrder S; S.init(MT, NGU, G, bx); pg8::EpiSwiGLU E{BIG, FF};
                  pg8::gemm_phase<pg8::EpiSwiGLU, pg8::StaticOrder, true, true>(lds, g, S, E); } SEAM(12);
    if (IN(13)) { pg8::Gemm g{BIG, (const bf16*)(ws + WS_WD1), MT, D, FF}; pg8::StaticOrder S; S.init(MT, D, G, bx); pg8::EpiF32 E{Y, D};
                  pg8::gemm_phase<pg8::EpiF32, pg8::StaticOrder, true, true>(lds, g, S, E); } SEAM(13);
    if (IN(14)) { rownorm_phase(Y, H, H + (size_t)NP * D, I.norm_g + 7 * 1024, H, nullptr, vcu, G, tid); }
#undef IN
#undef SEAM
}

#ifndef ONE_LAUNCH
#define ONE_LAUNCH 1
#endif
extern "C" void kernel_launch(void* const* d_in, const int* in_sizes, int n_in, void* d_out, int out_size, void* d_ws, size_t ws_size, hipStream_t stream) {
    static int grid = 0;
    if (grid == 0) {
        if (n_in != 19 || (size_t)out_size != OUT_TOTAL || ws_size < WS_END) { fprintf(stderr, "kernel_launch: unexpected shapes: n_in %d out %d ws %zu (need %zu)\n", n_in, out_size, ws_size, (size_t)WS_END); grid = -1; return; }
        int dev = 0, cus = 0, per_cu = 0;
        if (hipGetDevice(&dev) != hipSuccess || hipDeviceGetAttribute(&cus, hipDeviceAttributeMultiprocessorCount, dev) != hipSuccess) { grid = -1; return; }
        if (hipFuncSetAttribute((const void*)fwd, hipFuncAttributeMaxDynamicSharedMemorySize, LDS_BYTES) != hipSuccess) { fprintf(stderr, "kernel_launch: hipFuncSetAttribute failed\n"); grid = -1; return; }
        if (hipOccupancyMaxActiveBlocksPerMultiprocessor(&per_cu, (const void*)fwd, NWAVES * 64, LDS_BYTES) != hipSuccess || per_cu < 1) { fprintf(stderr, "kernel_launch: occupancy query says %d blocks per CU\n", per_cu); (void)hipGetLastError(); per_cu = 1; }
        grid = cus;
        if (grid > 256) grid = 256;
    }
    if (grid < 0) return;
    if (hipMemsetAsync((char*)d_ws + WS_CTL, 0, 65536, stream) != hipSuccess) { fprintf(stderr, "kernel_launch: hipMemsetAsync failed\n"); return; }
    Args a{};
    for (int i = 0; i < 19; ++i) a.in[i] = (const float*)d_in[i];
    a.out = (float*)d_out; a.ws = (unsigned char*)d_ws;
#if ONE_LAUNCH
    a.ph_lo = 0; a.ph_hi = NPHASE;
    void* args[] = {&a};
    hipError_t e = hipLaunchCooperativeKernel((const void*)fwd, dim3(grid), dim3(NWAVES * 64), args, LDS_BYTES, stream);
    if (e != hipSuccess) fprintf(stderr, "cooperative launch failed: %s (grid %d)\n", hipGetErrorString(e), grid);
#else
    for (int ph = 0; ph < NPHASE; ++ph) { a.ph_lo = ph; a.ph_hi = ph + 1; hipLaunchKernelGGL(fwd, dim3(grid), dim3(NWAVES * 64), LDS_BYTES, stream, a); }
#endif
}
```
